# Optimizing an MI355X kernel written in HIP

```python
import jax, jax.numpy as jnp
from jax import lax
import numpy as np

D_MODEL = 1024
BATCH = 8
SEQ = 4096
DEPTH = 1

N_META = 16
GRID_W = 64
D_ATTN = D_MODEL // 2
N_HEADS = 8
N_KV_HEADS = 2
HEAD_DIM = D_ATTN // N_HEADS
KV_GROUP = N_HEADS // N_KV_HEADS
D_KV = N_KV_HEADS * HEAD_DIM
ROPE_AXIS_PAIRS = HEAD_DIM // 4
ROPE_THETA = 10000.0
Q_BLOCK = 128
D_POOL = D_MODEL // 2
POOL_WINDOWS = (2, 4, 8, 16)
N_POOL_GROUPS = len(POOL_WINDOWS)
POOL_GROUP = D_POOL // N_POOL_GROUPS
D_MIX = D_ATTN + D_POOL
D_IN = D_ATTN + 2 * D_KV + D_POOL
D_FF = -(-8 * D_MODEL // (3 * 256)) * 256
EPS = 1e-6

kernel_name = "hybrid_gqa_axialrope_multiscale_pool_swiglu"


def rmsnorm(x, g):
    xf = x.astype(jnp.float32)
    y = xf * lax.rsqrt(jnp.mean(xf * xf, axis=-1, keepdims=True) + EPS)
    return (y * g.astype(jnp.float32)).astype(x.dtype)


def axial_rope_tables(L, n_real):
    rows = n_real // GRID_W
    t = jnp.arange(L, dtype=jnp.int32)
    r = t - N_META
    real = r >= 0
    row = jnp.where(real, r // GRID_W - rows // 2, 0).astype(jnp.float32)
    col = jnp.where(real, r % GRID_W - GRID_W // 2, 0).astype(jnp.float32)
    freqs = ROPE_THETA ** (-jnp.arange(ROPE_AXIS_PAIRS, dtype=jnp.float32) / ROPE_AXIS_PAIRS)
    ang = jnp.stack([row[:, None] * freqs, col[:, None] * freqs], axis=1)
    return jnp.cos(ang), jnp.sin(ang)


def apply_axial_rope(x, cos, sin):
    B, L, H, _ = x.shape
    xf = x.astype(jnp.float32).reshape(B, L, H, 2, 2, ROPE_AXIS_PAIRS)
    x0, x1 = xf[..., 0, :], xf[..., 1, :]
    c = cos[None, :, None]
    s = sin[None, :, None]
    out = jnp.stack([x0 * c - x1 * s, x0 * s + x1 * c], axis=-2)
    return out.reshape(x.shape).astype(x.dtype)


def attend_block(qb, k, v):
    B, Tq = qb.shape[0], qb.shape[1]
    qg = qb.reshape(B, Tq, N_KV_HEADS, KV_GROUP, HEAD_DIM)
    s = jnp.einsum('bqkgd,bskd->bkgqs', qg, k).astype(jnp.float32) * (HEAD_DIM ** -0.5)
    p = jax.nn.softmax(s, axis=-1).astype(v.dtype)
    o = jnp.einsum('bkgqs,bskd->bqkgd', p, v)
    return o.reshape(B, Tq, D_ATTN)


def gqa_bidirectional(q, k, v):
    B, L = q.shape[0], q.shape[1]
    n_real = L - N_META
    nb = n_real // Q_BLOCK
    out_meta = attend_block(q[:, :N_META], k, v)
    q_real = q[:, N_META:].reshape(B, nb, Q_BLOCK, N_HEADS, HEAD_DIM)
    q_real = jnp.moveaxis(q_real, 1, 0)
    out_real = lax.map(lambda qb: attend_block(qb, k, v), q_real)
    out_real = jnp.moveaxis(out_real, 0, 1).reshape(B, n_real, D_ATTN)
    return jnp.concatenate([out_meta, out_real], axis=1)


def multiscale_pool(u, w_pool):
    B, L, _ = u.shape
    t = jnp.arange(L, dtype=jnp.int32)
    diffs = []
    for gi, w in enumerate(POOL_WINDOWS):
        ug = u[..., gi * POOL_GROUP:(gi + 1) * POOL_GROUP].astype(jnp.float32)
        S = jnp.concatenate([jnp.zeros((B, 1, POOL_GROUP), jnp.float32),
                             jnp.cumsum(ug, axis=1)], axis=1)
        lo = jnp.clip(t - w // 2, 0, L)
        hi = jnp.clip(t + w - w // 2, 0, L)
        win_sum = jnp.take(S, hi, axis=1) - jnp.take(S, lo, axis=1)
        cnt = (hi - lo).astype(jnp.float32)[None, :, None]
        diffs.append(win_sum / cnt - ug)
    d = jnp.stack(diffs, axis=2).astype(u.dtype)
    y = jnp.einsum('blgc,gcd->blgd', d, w_pool)
    return y.reshape(B, L, D_POOL)


def setup_inputs(seed: int = 0) -> dict:
    key = jax.random.key(seed)
    ks = jax.random.split(key, 14)
    f32 = jnp.float32

    def gain(k, shape):
        return 1.0 + 0.05 * jax.random.normal(k, shape, f32)

    return {
        "x": jax.random.normal(ks[0], (BATCH, SEQ, D_MODEL), f32),
        "meta_tokens": jax.random.normal(ks[1], (N_META, D_MODEL), f32),
        "norm_mix": gain(ks[2], (DEPTH, D_MODEL)),
        "w_in": jax.random.normal(ks[3], (DEPTH, D_MODEL, D_IN), f32) * D_MODEL ** -0.5,
        "q_norm": gain(ks[4], (DEPTH, HEAD_DIM)),
        "k_norm": gain(ks[5], (DEPTH, HEAD_DIM)),
        "attn_out_norm": gain(ks[6], (DEPTH, D_ATTN)),
        "w_pool": jax.random.normal(ks[7], (DEPTH, N_POOL_GROUPS, POOL_GROUP, POOL_GROUP), f32) * POOL_GROUP ** -0.5,
        "pool_scale": gain(ks[8], (DEPTH, D_POOL)),
        "w_out": jax.random.normal(ks[9], (DEPTH, D_MIX, D_MODEL), f32) * D_MIX ** -0.5,
        "norm_ffn": gain(ks[10], (DEPTH, D_MODEL)),
        "w_ffn_in": jax.random.normal(ks[11], (DEPTH, D_MODEL, 2 * D_FF), f32) * D_MODEL ** -0.5,
        "w_ffn_down": jax.random.normal(ks[12], (DEPTH, D_FF, D_MODEL), f32) * D_FF ** -0.5,
        "norm_final": gain(ks[13], (D_MODEL,)),
    }


def reference(x, meta_tokens, norm_mix, w_in, q_norm, k_norm, attn_out_norm,
              w_pool, pool_scale, w_out, norm_ffn, w_ffn_in, w_ffn_down, norm_final):
    B, n_real, _ = x.shape
    meta = jnp.broadcast_to(meta_tokens[None].astype(x.dtype), (B, N_META, D_MODEL))
    h_res = jnp.concatenate([meta, x], axis=1)
    L = N_META + n_real
    cos, sin = axial_rope_tables(L, n_real)

    for l in range(DEPTH):
        h = rmsnorm(h_res, norm_mix[l])
        proj = h @ w_in[l]
        q = proj[..., :D_ATTN].reshape(B, L, N_HEADS, HEAD_DIM)
        k = proj[..., D_ATTN:D_ATTN + D_KV].reshape(B, L, N_KV_HEADS, HEAD_DIM)
        v = proj[..., D_ATTN + D_KV:D_ATTN + 2 * D_KV].reshape(B, L, N_KV_HEADS, HEAD_DIM)
        u = proj[..., D_ATTN + 2 * D_KV:]

        q = apply_axial_rope(rmsnorm(q, q_norm[l]), cos, sin)
        k = apply_axial_rope(rmsnorm(k, k_norm[l]), cos, sin)
        attn = rmsnorm(gqa_bidirectional(q, k, v), attn_out_norm[l])
        pool = rmsnorm(multiscale_pool(u, w_pool[l]), pool_scale[l])

        mixed = jnp.concatenate([attn, pool], axis=-1)
        h_res = h_res + mixed @ w_out[l]

        h = rmsnorm(h_res, norm_ffn[l])
        gu = h @ w_ffn_in[l]
        h_res = h_res + (jax.nn.silu(gu[..., :D_FF]) * gu[..., D_FF:]) @ w_ffn_down[l]

    return rmsnorm(h_res, norm_final)[:, N_META:]
```

```cpp
#include <hip/hip_runtime.h>
#include <hip/hip_cooperative_groups.h>
#include <cstdio>
#include <cstdint>
namespace cg = cooperative_groups;

typedef unsigned short bf16_t;
typedef float f32x4 __attribute__((ext_vector_type(4)));
typedef unsigned u32x4 __attribute__((ext_vector_type(4)));

constexpr int NB = 8, SEQ = 4096, DM = 1024, NMETA = 16;
constexpr int MR = NB * SEQ;
constexpr int MP = 33024;
constexpr int DATT = 512, DKV = 128, DPOOL = 512, DIN = 1280, DFF = 2816;
constexpr int LKEYS = SEQ + NMETA;
constexpr float EPS = 1e-6f;
constexpr float C2 = 0.125f * 1.4426950408889634f;

constexpr size_t MiB = 1u << 20;
constexpr size_t WS_ROPE = 1 * MiB;
constexpr size_t WS_HN = 24 * MiB;
constexpr size_t WS_Q = 89 * MiB;
constexpr size_t WS_K = 122 * MiB;
constexpr size_t WS_V = 131 * MiB;
constexpr size_t WS_U = 140 * MiB;
constexpr size_t WS_MIX = 173 * MiB;
constexpr size_t WS_A2 = 237 * MiB;
constexpr size_t WS_SSQ2 = 301 * MiB;
constexpr size_t WS_SSQ3 = 303 * MiB;
constexpr size_t WS_ACT = 24 * MiB;

constexpr int NTHREADS = 512;
constexpr int LDS_BYTES = 147456;

struct Args { const float* in[14]; float* out; unsigned char* ws; };

__device__ __forceinline__ unsigned f2bf(float f) { unsigned u = __builtin_bit_cast(unsigned, f); return (u + 0x7fffu + ((u >> 16) & 1u)) >> 16; }
__device__ __forceinline__ float bf2f(unsigned h) { return __builtin_bit_cast(float, h << 16); }
__device__ __forceinline__ unsigned pk2(float lo, float hi) { return f2bf(lo) | (f2bf(hi) << 16); }
__device__ __forceinline__ float wave_sum(float v) {
#pragma unroll
    for (int o = 1; o < 64; o <<= 1) v += __shfl_xor(v, o);
    return v;
}
__device__ __forceinline__ float wave_max(float v) {
#pragma unroll
    for (int o = 1; o < 64; o <<= 1) v = fmaxf(v, __shfl_xor(v, o));
    return v;
}

__device__ __forceinline__ void rope_table(float* tab) {
    for (int idx = blockIdx.x * NTHREADS + threadIdx.x; idx < 64 * 16; idx += gridDim.x * NTHREADS) {
        const int ci = idx >> 4, i = idx & 15;
        const int lo = i & 3, hi = i >> 2;
        double f = lo == 0 ? 1.0 : lo == 1 ? 0.5623413251903491 : lo == 2 ? 0.31622776601683794 : 0.1778279410038923;
        f *= hi == 0 ? 1.0 : hi == 1 ? 0.1 : hi == 2 ? 0.01 : 0.001;
        const float ang_f = (float)(ci - 32) * (float)f;
        double a = (double)ang_f;
        a -= 6.283185307179586 * __builtin_rint(a * 0.15915494309189535);
        const double a2 = a * a;
        double sn = a, cs = 1.0, ts = a, tc = 1.0;
        for (int k = 1; k <= 16; ++k) {
            tc *= -a2 / (double)((2 * k - 1) * (2 * k));
            ts *= -a2 / (double)((2 * k) * (2 * k + 1));
            cs += tc; sn += ts;
        }
        tab[2 * idx] = (float)cs; tab[2 * idx + 1] = (float)sn;
    }
}
__device__ __forceinline__ void rms_rows_p0(const float* x, const float* meta, const float* g, bf16_t* HN) {
    const int lane = threadIdx.x & 63, gw = blockIdx.x * 8 + (threadIdx.x >> 6), NGW = gridDim.x * 8;
    f32x4 gv[4];
#pragma unroll
    for (int j = 0; j < 4; ++j) gv[j] = *((const f32x4*)g + lane + 64 * j);
    for (int m = gw; m < MP; m += NGW) {
        unsigned long long* o8 = (unsigned long long*)(HN + (size_t)m * DM) + lane;
        if (m >= MR + NMETA) {
#pragma unroll
            for (int j = 0; j < 4; ++j) o8[64 * j] = 0ull;
            continue;
        }
        const float* src = m < MR ? x + (size_t)m * DM : meta + (size_t)(m - MR) * DM;
        const f32x4* xr = (const f32x4*)src + lane;
        f32x4 v[4]; float s = 0.f;
#pragma unroll
        for (int j = 0; j < 4; ++j) { v[j] = xr[64 * j]; s += (v[j].x * v[j].x + v[j].y * v[j].y) + (v[j].z * v[j].z + v[j].w * v[j].w); }
        const float rs = 1.0f / sqrtf(wave_sum(s) * (1.f / DM) + EPS);
#pragma unroll
        for (int j = 0; j < 4; ++j) {
            const f32x4 y = v[j] * rs * gv[j];
            o8[64 * j] = (unsigned long long)pk2(y.x, y.y) | ((unsigned long long)pk2(y.z, y.w) << 32);
        }
    }
}

template <bool DUAL, class Epi>
__device__ __forceinline__ void naive_gemm(float* As, const bf16_t* A, int lda, const float* kgain, const float* W, int ldw, int Nout, int K, int Mrows, int dual_off, const Epi& epi) {
    const int tid = threadIdx.x, cl = tid & 255, rh = tid >> 8;
    const int tilesN = Nout / 256, tilesM = Mrows / 64;
    for (int tile = blockIdx.x; tile < tilesM * tilesN; tile += gridDim.x) {
        const int tm = tile / tilesN, tn = tile % tilesN;
        const int n = tn * 256 + cl;
        float acc[32], acc2[32];
#pragma unroll
        for (int r = 0; r < 32; ++r) { acc[r] = 0.f; acc2[r] = 0.f; }
        for (int k0 = 0; k0 < K; k0 += 64) {
            __syncthreads();
            {
                const int r = tid >> 3, kc = (tid & 7) * 8;
                const u32x4 v = *(const u32x4*)(A + (size_t)(tm * 64 + r) * lda + k0 + kc);
                float f[8];
                f[0] = bf2f(v.x & 0xffffu); f[1] = bf2f(v.x >> 16); f[2] = bf2f(v.y & 0xffffu); f[3] = bf2f(v.y >> 16);
                f[4] = bf2f(v.z & 0xffffu); f[5] = bf2f(v.z >> 16); f[6] = bf2f(v.w & 0xffffu); f[7] = bf2f(v.w >> 16);
                if (kgain) {
#pragma unroll
                    for (int i = 0; i < 8; ++i) f[i] *= kgain[k0 + kc + i];
                }
#pragma unroll
                for (int i = 0; i < 8; ++i) As[r * 64 + kc + i] = f[i];
            }
            __syncthreads();
#pragma unroll 2
            for (int k4 = 0; k4 < 16; ++k4) {
                float b[4], b2[4];
#pragma unroll
                for (int j = 0; j < 4; ++j) {
                    b[j] = W[(size_t)(k0 + 4 * k4 + j) * ldw + n];
                    b2[j] = DUAL ? W[(size_t)(k0 + 4 * k4 + j) * ldw + n + dual_off] : 0.f;
                }
#pragma unroll
                for (int r = 0; r < 32; ++r) {
                    const f32x4 a = *(const f32x4*)&As[(rh * 32 + r) * 64 + 4 * k4];
                    acc[r] += a.x * b[0] + a.y * b[1] + a.z * b[2] + a.w * b[3];
                    if (DUAL) acc2[r] += a.x * b2[0] + a.y * b2[1] + a.z * b2[2] + a.w * b2[3];
                }
            }
        }
#pragma unroll
        for (int r = 0; r < 32; ++r) epi(tm * 64 + rh * 32 + r, n, acc[r], acc2[r]);
    }
}

struct EpiIn {
    const float* qn; const float* kn; const float* rope; bf16_t* Q; bf16_t* K; bf16_t* V; bf16_t* U;
    __device__ __forceinline__ void operator()(int m, int col, float v, float) const {
        const int g = col >> 6, j = col & 63;
        if (g < 10) {
            const float ssq = wave_sum(v * v);
            const float rn = 1.0f / sqrtf(ssq * (1.f / 64.f) + EPS);
            const float y = v * rn * (g < 8 ? qn[j] : kn[j]);
            const float partner = __shfl_xor(y, 16);
            float c = 1.f, s = 0.f;
            if (m < MR) {
                const int sidx = m & (SEQ - 1);
                const int ci = (j < 32) ? (sidx >> 6) : (sidx & 63);
                c = rope[(ci * 16 + (j & 15)) * 2]; s = rope[(ci * 16 + (j & 15)) * 2 + 1];
            }
            float o = ((j >> 4) & 1) ? (partner * s + y * c) : (y * c - partner * s);
            if (g < 8) { o *= C2; Q[(size_t)m * DATT + g * 64 + j] = (bf16_t)f2bf(o); }
            else K[(size_t)m * DKV + (g - 8) * 64 + j] = (bf16_t)f2bf(o);
        } else if (g < 12) V[(size_t)m * DKV + (g - 10) * 64 + j] = (bf16_t)f2bf(v);
        else U[(size_t)m * DPOOL + (g - 12) * 64 + j] = (bf16_t)f2bf(v);
    }
};
struct EpiOut {
    const float* x; float* out; bf16_t* A2; float* ssq;
    __device__ __forceinline__ void operator()(int m, int col, float v, float) const {
        const float h = v + x[(size_t)m * DM + col];
        out[(size_t)m * DM + col] = h; A2[(size_t)m * DM + col] = (bf16_t)f2bf(h);
        const float s = wave_sum(h * h);
        if ((threadIdx.x & 63) == 0) ssq[(size_t)m * 16 + (col >> 6)] = s;
    }
};
struct EpiFfnIn {
    const float* ssq; bf16_t* ACT;
    __device__ __forceinline__ void operator()(int m, int col, float g, float u) const {
        float t = 0.f;
#pragma unroll
        for (int i = 0; i < 16; ++i) t += ssq[(size_t)m * 16 + i];
        const float rs = 1.0f / sqrtf(t * (1.f / DM) + EPS);
        g *= rs; u *= rs;
        const float a = g / (1.f + __expf(-g)) * u;
        ACT[(size_t)m * DFF + col] = (bf16_t)f2bf(a);
    }
};
struct EpiDown {
    float* out; float* ssq;
    __device__ __forceinline__ void operator()(int m, int col, float v, float) const {
        const float y = v + out[(size_t)m * DM + col];
        out[(size_t)m * DM + col] = y;
        const float s = wave_sum(y * y);
        if ((threadIdx.x & 63) == 0) ssq[(size_t)m * 16 + (col >> 6)] = s;
    }
};

__device__ __forceinline__ void naive_attn(float* lds, const bf16_t* Q, const bf16_t* K, const bf16_t* V, const float* gain, bf16_t* MIX) {
    const int tid = threadIdx.x, wid = tid >> 6, lane = tid & 63;
    float* sc = lds + wid * 4160;
    float* red = lds + 8 * 4160;
    const int kvh = wid >> 2;
    for (int m = blockIdx.x; m < MR; m += gridDim.x) {
        const int b = m >> 12;
        float q[64];
        {
            const u32x4* qp = (const u32x4*)(Q + (size_t)m * DATT + wid * 64);
#pragma unroll
            for (int i = 0; i < 8; ++i) { const u32x4 v = qp[i];
                q[8 * i + 0] = bf2f(v.x & 0xffffu); q[8 * i + 1] = bf2f(v.x >> 16); q[8 * i + 2] = bf2f(v.y & 0xffffu); q[8 * i + 3] = bf2f(v.y >> 16);
                q[8 * i + 4] = bf2f(v.z & 0xffffu); q[8 * i + 5] = bf2f(v.z >> 16); q[8 * i + 6] = bf2f(v.w & 0xffffu); q[8 * i + 7] = bf2f(v.w >> 16); }
        }
        float mx = -INFINITY;
        for (int j0 = 0; j0 < LKEYS; j0 += 64) {
            const int j = j0 + lane;
            if (j < LKEYS) {
                const int row = j < SEQ ? b * SEQ + j : MR + (j - SEQ);
                const u32x4* kp = (const u32x4*)(K + (size_t)row * DKV + kvh * 64);
                float s = 0.f;
#pragma unroll
                for (int i = 0; i < 8; ++i) { const u32x4 v = kp[i];
                    s += q[8 * i + 0] * bf2f(v.x & 0xffffu) + q[8 * i + 1] * bf2f(v.x >> 16) + q[8 * i + 2] * bf2f(v.y & 0xffffu) + q[8 * i + 3] * bf2f(v.y >> 16)
                       + q[8 * i + 4] * bf2f(v.z & 0xffffu) + q[8 * i + 5] * bf2f(v.z >> 16) + q[8 * i + 6] * bf2f(v.w & 0xffffu) + q[8 * i + 7] * bf2f(v.w >> 16); }
                sc[j] = s; mx = fmaxf(mx, s);
            }
        }
        mx = wave_max(mx);
        float l = 0.f;
        for (int j0 = 0; j0 < LKEYS; j0 += 64) {
            const int j = j0 + lane;
            if (j < LKEYS) { const float p = __builtin_amdgcn_exp2f(sc[j] - mx); sc[j] = p; l += p; }
        }
        l = wave_sum(l);
        __syncthreads();
        float o = 0.f;
        const bf16_t* vb = V + kvh * 64 + lane;
#pragma unroll 8
        for (int j = 0; j < LKEYS; ++j) {
            const int row = j < SEQ ? b * SEQ + j : MR + (j - SEQ);
            o += sc[j] * bf2f(vb[(size_t)row * DKV]);
        }
        o /= l;
        const float ss = wave_sum(o * o);
        if (lane == 0) red[wid] = ss;
        __syncthreads();
        float t = 0.f;
#pragma unroll
        for (int i = 0; i < 8; ++i) t += red[i];
        const float rs = 1.0f / sqrtf(t * (1.f / DATT) + EPS);
        MIX[(size_t)m * DM + wid * 64 + lane] = (bf16_t)f2bf(o * rs * gain[wid * 64 + lane]);
        __syncthreads();
    }
}

__device__ __forceinline__ void pool_phase(float* lds, const bf16_t* U, const float* wpool, const float* pscale, bf16_t* MIX) {
    const int tid = threadIdx.x, wid = tid >> 6, lane = tid & 63;
    float* dl = lds;
    float* red = lds + 16 * 512;
    const int g = tid >> 7, dch = tid & 127;
    const int w2 = 1 << g;
    for (int blk = blockIdx.x; blk < MR / 16; blk += gridDim.x) {
        const int m0 = blk * 16;
        __syncthreads();
        for (int t = 0; t < 16; ++t) {
            const int m = m0 + t, b = m >> 12, s = m & (SEQ - 1);
            const int lo = s - w2;
            const int hi = (s + w2 < SEQ) ? s + w2 : SEQ;
            float sum = 0.f;
            for (int r = lo; r < hi; ++r) {
                const int row = r >= 0 ? b * SEQ + r : MR + NMETA + r;
                sum += bf2f(U[(size_t)row * DPOOL + tid]);
            }
            const float self = bf2f(U[(size_t)m * DPOOL + tid]);
            dl[t * 512 + tid] = sum / (float)(hi - lo) - self;
        }
        __syncthreads();
        float acc[16];
#pragma unroll
        for (int t = 0; t < 16; ++t) acc[t] = 0.f;
        const float* wp = wpool + (size_t)g * 128 * 128 + dch;
        for (int c4 = 0; c4 < 32; ++c4) {
            float w[4];
#pragma unroll
            for (int i = 0; i < 4; ++i) w[i] = wp[(size_t)(4 * c4 + i) * 128];
#pragma unroll
            for (int t = 0; t < 16; ++t) {
                const f32x4 a = *(const f32x4*)&dl[t * 512 + g * 128 + 4 * c4];
                acc[t] += a.x * w[0] + a.y * w[1] + a.z * w[2] + a.w * w[3];
            }
        }
#pragma unroll
        for (int t = 0; t < 16; ++t) { const float s = wave_sum(acc[t] * acc[t]); if (lane == 0) red[t * 8 + wid] = s; }
        __syncthreads();
        const float ps = pscale[tid];
#pragma unroll
        for (int t = 0; t < 16; ++t) {
            float tot = 0.f;
#pragma unroll
            for (int i = 0; i < 8; ++i) tot += red[t * 8 + i];
            const float rs = 1.0f / sqrtf(tot * (1.f / DPOOL) + EPS);
            MIX[(size_t)(m0 + t) * DM + DATT + tid] = (bf16_t)f2bf(acc[t] * rs * ps);
        }
    }
}

__device__ __forceinline__ void final_norm(float* out, const float* ssq, const float* g) {
    const int lane = threadIdx.x & 63, gw = blockIdx.x * 8 + (threadIdx.x >> 6), NGW = gridDim.x * 8;
    f32x4 gv[4];
#pragma unroll
    for (int j = 0; j < 4; ++j) gv[j] = *((const f32x4*)g + lane + 64 * j);
    for (int m = gw; m < MR; m += NGW) {
        float t = 0.f;
#pragma unroll
        for (int i = 0; i < 16; ++i) t += ssq[(size_t)m * 16 + i];
        const float rs = 1.0f / sqrtf(t * (1.f / DM) + EPS);
        f32x4* xr = (f32x4*)(out + (size_t)m * DM) + lane;
#pragma unroll
        for (int j = 0; j < 4; ++j) xr[64 * j] = xr[64 * j] * rs * gv[j];
    }
}

__global__ void __launch_bounds__(NTHREADS, 2) fwd_kernel(Args args) {
    extern __shared__ __attribute__((aligned(16))) unsigned char lds_raw[];
    float* lds = (float*)lds_raw;
    cg::grid_group grid = cg::this_grid();
    unsigned char* ws = args.ws;
    const float* x = args.in[0]; const float* meta = args.in[1]; const float* norm_mix = args.in[2]; const float* w_in = args.in[3];
    const float* q_norm = args.in[4]; const float* k_norm = args.in[5]; const float* attn_out_norm = args.in[6]; const float* w_pool = args.in[7];
    const float* pool_scale = args.in[8]; const float* w_out = args.in[9]; const float* norm_ffn = args.in[10]; const float* w_ffn_in = args.in[11];
    const float* w_ffn_down = args.in[12]; const float* norm_final = args.in[13];
    float* rope = (float*)(ws + WS_ROPE);
    bf16_t* HN = (bf16_t*)(ws + WS_HN); bf16_t* Q = (bf16_t*)(ws + WS_Q); bf16_t* K = (bf16_t*)(ws + WS_K); bf16_t* V = (bf16_t*)(ws + WS_V);
    bf16_t* U = (bf16_t*)(ws + WS_U); bf16_t* MIX = (bf16_t*)(ws + WS_MIX); bf16_t* A2 = (bf16_t*)(ws + WS_A2); bf16_t* ACT = (bf16_t*)(ws + WS_ACT);
    float* SSQ2 = (float*)(ws + WS_SSQ2); float* SSQ3 = (float*)(ws + WS_SSQ3);

    rope_table(rope);
    rms_rows_p0(x, meta, norm_mix, HN);
    grid.sync();
    { EpiIn e{q_norm, k_norm, rope, Q, K, V, U}; naive_gemm<false>(lds, HN, DM, nullptr, w_in, DIN, DIN, DM, MP, 0, e); }
    grid.sync();
    naive_attn(lds, Q, K, V, attn_out_norm, MIX);
    pool_phase(lds, U, w_pool, pool_scale, MIX);
    grid.sync();
    { EpiOut e{x, args.out, A2, SSQ2}; naive_gemm<false>(lds, MIX, DM, nullptr, w_out, DM, DM, DM, MR, 0, e); }
    grid.sync();
    { EpiFfnIn e{SSQ2, ACT}; naive_gemm<true>(lds, A2, DM, norm_ffn, w_ffn_in, 2 * DFF, DFF, DM, MR, DFF, e); }
    grid.sync();
    { EpiDown e{args.out, SSQ3}; naive_gemm<false>(lds, ACT, DFF, nullptr, w_ffn_down, DM, DM, DFF, MR, 0, e); }
    grid.sync();
    final_norm(args.out, SSQ3, norm_final);
}

extern "C" void kernel_launch(void* const* d_in, const int* in_sizes, int n_in, void* d_out, int out_size, void* d_ws, size_t ws_size, hipStream_t stream) {
    static int grid = 0;
    if (grid == 0) {
        int dev = 0, cus = 0, per_cu = 0;
        hipGetDevice(&dev);
        hipDeviceGetAttribute(&cus, hipDeviceAttributeMultiprocessorCount, dev);
        hipFuncSetAttribute((const void*)fwd_kernel, hipFuncAttributeMaxDynamicSharedMemorySize, LDS_BYTES);
        hipOccupancyMaxActiveBlocksPerMultiprocessor(&per_cu, (const void*)fwd_kernel, NTHREADS, LDS_BYTES);
        if (per_cu < 1) { fprintf(stderr, "kernel_launch: occupancy query says %d blocks per CU\n", per_cu); per_cu = 1; }
        (void)hipGetLastError();
        grid = cus;
    }
    Args a{};
    for (int i = 0; i < 14; ++i) a.in[i] = (const float*)d_in[i];
    a.out = (float*)d_out; a.ws = (unsigned char*)d_ws;
    void* params[] = {&a};
    hipError_t e = hipLaunchCooperativeKernel((const void*)fwd_kernel, dim3(grid), dim3(NTHREADS), params, LDS_BYTES, stream);
    if (e != hipSuccess) fprintf(stderr, "cooperative launch failed: %s (grid %d)\n", hipGetErrorString(e), grid);
}
```

```cpp
#include <hip/hip_runtime.h>
#include <hip/hip_cooperative_groups.h>
#include <cstdio>
#include <cstdint>
namespace cg = cooperative_groups;

typedef unsigned short bf16_t;
typedef float f32x4 __attribute__((ext_vector_type(4)));
typedef unsigned u32x4 __attribute__((ext_vector_type(4)));

constexpr int NB = 8, SEQ = 4096, DM = 1024, NMETA = 16;
constexpr int MR = NB * SEQ;
constexpr int MP = 33024;
constexpr int DATT = 512, DKV = 128, DPOOL = 512, DIN = 1280, DFF = 2816;
constexpr int LKEYS = SEQ + NMETA;
constexpr float EPS = 1e-6f;
constexpr float C2 = 0.125f * 1.4426950408889634f;

constexpr size_t MiB = 1u << 20;
constexpr size_t WS_ROPE = 1 * MiB;
constexpr size_t WS_WIN = 2 * MiB, WS_WOUT = 5 * MiB, WS_WFI = 7 * MiB, WS_WFD = 18 * MiB, WS_WPOOL = 23 * MiB + 512 * 1024;
constexpr size_t WS_HN = 24 * MiB;
constexpr size_t WS_Q = 89 * MiB;
constexpr size_t WS_K = 122 * MiB;
constexpr size_t WS_V = 131 * MiB;
constexpr size_t WS_U = 140 * MiB;
constexpr size_t WS_MIX = 173 * MiB;
constexpr size_t WS_A2 = 237 * MiB;
constexpr size_t WS_SSQ2 = 301 * MiB;
constexpr size_t WS_SSQ3 = 303 * MiB;
constexpr size_t WS_ACT = 24 * MiB;

constexpr int NTHREADS = 512;
constexpr int LDS_BYTES = 147456;

struct Args { const float* in[14]; float* out; unsigned char* ws; };

__device__ __forceinline__ unsigned f2bf(float f) { unsigned u = __builtin_bit_cast(unsigned, f); return (u + 0x7fffu + ((u >> 16) & 1u)) >> 16; }
__device__ __forceinline__ float bf2f(unsigned h) { return __builtin_bit_cast(float, h << 16); }
__device__ __forceinline__ unsigned pk2(float lo, float hi) { return f2bf(lo) | (f2bf(hi) << 16); }
__device__ __forceinline__ float wave_sum(float v) {
#pragma unroll
    for (int o = 1; o < 64; o <<= 1) v += __shfl_xor(v, o);
    return v;
}
__device__ __forceinline__ float wave_max(float v) {
#pragma unroll
    for (int o = 1; o < 64; o <<= 1) v = fmaxf(v, __shfl_xor(v, o));
    return v;
}

namespace pg8 {
#define PG8_LAS __attribute__((address_space(3)))
typedef unsigned short bf16_t;
typedef short bf16x8 __attribute__((ext_vector_type(8)));
typedef float f32x4 __attribute__((ext_vector_type(4)));
typedef unsigned u32x4 __attribute__((ext_vector_type(4)));
constexpr int BM = 256, BK = 64, HALF = 128, HTB = HALF * BK * 2  , STAGE_BYTES = 8 * HTB, NXCD = 8, WGM = 8;

__host__ __device__ __forceinline__ int lds_byte(int r, int c) { const int st = (r >> 4) * 2 + (c >> 5), rr = r & 15, cc = c & 31, ob = rr * 64 + cc * 2; return st * 1024 + (ob ^ (((ob >> 9) & 1) << 5)); }
__host__ __device__ __forceinline__ void stage_rc(int b, int& R, int& C) { const int st = b / 1024, sb = b % 1024, swz = sb ^ (((sb >> 9) & 1) << 5); R = (st >> 1) * 16 + swz / 64; C = (st & 1) * 32 + (swz % 64) / 2; }
__host__ __device__ __forceinline__ int perm32(int rho) { const int n = rho >> 4, i = rho & 15; return 8 * (i >> 2) + 4 * n + (i & 3); }

struct Unit { int pm, pn; };
struct Gemm { const bf16_t* A; const bf16_t* Bt; int M, N, K; };

struct StaticOrder {
    int nM, nN, nwg, G, c;
    __host__ __device__ void init(int M, int N, int G_, int c_) { nM = M / BM; nN = N / BM; nwg = nM * nN; G = G_; c = c_; }
    __host__ __device__ bool next(int i, Unit& u) const {
        const long L = (long)i * G + c; if (L >= nwg) return false;
        int wgid = (int)L; { const int q = nwg / NXCD, r = nwg % NXCD, xcd = wgid % NXCD, off = wgid / NXCD; wgid = (xcd < r ? xcd * (q + 1) : r * (q + 1) + (xcd - r) * q) + off; }
        const int nig = WGM * nN, gid = wgid / nig, fm = gid * WGM, gsz = (nM - fm) < WGM ? (nM - fm) : WGM;
        u.pm = fm + ((wgid % nig) % gsz); u.pn = (wgid % nig) / gsz; return true;
    }
    __device__ __forceinline__ void a_ready(const Unit&) const {}
    __device__ __forceinline__ void done(const Unit&) const {}
};

__device__ __forceinline__ unsigned cvt_pk_bf16(float lo, float hi) { unsigned r; asm volatile("v_cvt_pk_bf16_f32 %0, %1, %2" : "=v"(r) : "v"(lo), "v"(hi)); return r; }
typedef float f32x2 __attribute__((ext_vector_type(2)));
template <class Epi, class Sched, bool ALIGN_EPI = false, bool SP2 = false>
__device__ __forceinline__ void gemm_phase(PG8_LAS unsigned char* lds, const Gemm g, const Sched& S, const Epi& E) {
    int tid_ = threadIdx.x; asm volatile("" : "+v"(tid_));
    const int tid = tid_, wid = __builtin_amdgcn_readfirstlane(tid >> 6), lane = tid & 63, wr = wid >> 2, wc = wid & 3, fr = lane & 15, fq = lane >> 4;
    const int K = g.K, nt = K / BK;
    unsigned voffA[2], voffB[2];
#pragma unroll
    for (int i = 0; i < 2; ++i) { int R, C; stage_rc(tid * 16 + i * 8192, R, C); const int Rb = Epi::PERM ? ((R & ~31) + perm32(R & 31)) : R;
        voffA[i] = (unsigned)(R * K + C) * 2u; voffB[i] = (unsigned)(Rb * K + C) * 2u; }
    const size_t kstep = (size_t)(BK * 2);
    const size_t hstep = (size_t)HALF * K * 2;
    const size_t tstep = 2 * hstep;
    const unsigned ldsw = (unsigned)wid * 1024u;
    const int aoff = lds_byte(wr * 64 + fr, fq * 8), boff = lds_byte(wc * 32 + fr, fq * 8);
#define PG8_SA(b, h) (((b) * 2 + (h)) * HTB)
#define PG8_SB(b, h) ((4 + (b) * 2 + (h)) * HTB)
#define PG8_STAGE(bufoff, gbase, voff) do { _Pragma("unroll") for (int _i = 0; _i < 2; ++_i) \
        __builtin_amdgcn_global_load_lds((const unsigned*)((const char*)(gbase) + (voff)[_i]), (PG8_LAS unsigned*)(lds + (bufoff) + ldsw + _i * 8192), 16, 0, 0); } while (0)
#define PG8_LDA(dst, b, h) do { _Pragma("unroll") for (int m = 0; m < 4; ++m) _Pragma("unroll") for (int k = 0; k < 2; ++k) dst[m][k] = *(const PG8_LAS bf16x8*)(lds + PG8_SA(b, h) + aoff + m * 2048 + k * 1024); } while (0)
#define PG8_LDB(dst, b, h) do { _Pragma("unroll") for (int n = 0; n < 2; ++n) _Pragma("unroll") for (int k = 0; k < 2; ++k) dst[n][k] = *(const PG8_LAS bf16x8*)(lds + PG8_SB(b, h) + boff + n * 2048 + k * 1024); } while (0)
#define PG8_MMA(ai, bj, At, Bt) do { __builtin_amdgcn_s_setprio(1); _Pragma("unroll") for (int m = 0; m < 4; ++m) _Pragma("unroll") for (int n = 0; n < 2; ++n) _Pragma("unroll") for (int k = 0; k < 2; ++k) \
        acc[ai][bj][m][n] = __builtin_amdgcn_mfma_f32_16x16x32_bf16(Bt[n][k], At[m][k], acc[ai][bj][m][n], 0, 0, 0); __builtin_amdgcn_s_setprio(0); } while (0)
#define PG8_WAIT_V(n) asm volatile("s_waitcnt vmcnt(" #n ")" ::: "memory")
#define PG8_WAIT_L(n) asm volatile("s_waitcnt lgkmcnt(" #n ")" ::: "memory")
#define PG8_BAR __builtin_amdgcn_s_barrier()
#define PG8_SCHED __builtin_amdgcn_sched_barrier(0)
    Unit cur, nxt; int ui = 0;
    if (!S.next(0, cur)) return;
    f32x4 acc[2][2][4][2];
#pragma unroll
    for (int a = 0; a < 2; ++a)
#pragma unroll
        for (int b = 0; b < 2; ++b)
#pragma unroll
            for (int m = 0; m < 4; ++m)
#pragma unroll
                for (int n = 0; n < 2; ++n) acc[a][b][m][n] = (f32x4){0.f, 0.f, 0.f, 0.f};
    bf16x8 At[4][2], B0[2][2], B1[2][2];
    const char* cA = (const char*)g.A + (size_t)cur.pm * tstep; const char* cB = (const char*)g.Bt + (size_t)cur.pn * tstep;
    S.a_ready(cur);
    if constexpr (SP2) {
        PG8_STAGE(PG8_SB(0, 0), cB, voffB); PG8_STAGE(PG8_SB(0, 1), cB + hstep, voffB); PG8_STAGE(PG8_SA(0, 0), cA, voffA); PG8_STAGE(PG8_SA(0, 1), cA + hstep, voffA);
        if (wr == 1) PG8_BAR;
        PG8_WAIT_V(2); PG8_BAR;
        PG8_STAGE(PG8_SB(1, 0), cB + kstep, voffB); PG8_STAGE(PG8_SA(1, 0), cA + kstep, voffA); PG8_STAGE(PG8_SB(1, 1), cB + hstep + kstep, voffB);
        PG8_WAIT_V(6); PG8_BAR;
    } else {
        PG8_STAGE(PG8_SB(0, 0), cB, voffB); PG8_STAGE(PG8_SA(0, 0), cA, voffA); PG8_STAGE(PG8_SB(0, 1), cB + hstep, voffB); PG8_STAGE(PG8_SA(0, 1), cA + hstep, voffA);
        if (wr == 1) PG8_BAR;
        PG8_WAIT_V(4); PG8_BAR;
        PG8_STAGE(PG8_SB(1, 0), cB + kstep, voffB); PG8_STAGE(PG8_SA(1, 0), cA + kstep, voffA); PG8_STAGE(PG8_SB(1, 1), cB + hstep + kstep, voffB);
        PG8_WAIT_V(6); PG8_BAR;
    }
    for (;;) {
        const bool has_next = S.next(ui + 1, nxt);
        const char* nA = has_next ? (const char*)g.A + (size_t)nxt.pm * tstep : cA; const char* nB = has_next ? (const char*)g.Bt + (size_t)nxt.pn * tstep : cB;
        for (int t = 0; t < nt; t += 2) {
            const bool last = (t == nt - 2);
            const char* a1 = cA + (size_t)(t + 1) * kstep;
            const char* a2 = last ? nA : cA + (size_t)(t + 2) * kstep; const char* b2 = last ? nB : cB + (size_t)(t + 2) * kstep;
            const char* a3 = a2 + kstep; const char* b3 = b2 + kstep;
            if (last && has_next) S.a_ready(nxt);
            if constexpr (SP2) {
            PG8_LDB(B0, 0, 0); PG8_LDB(B1, 0, 1); PG8_SCHED; PG8_LDA(At, 0, 0); PG8_STAGE(PG8_SA(1, 1), a1 + hstep, voffA);
            PG8_WAIT_V(8); PG8_WAIT_L(0); PG8_BAR; PG8_MMA(0, 0, At, B0); PG8_MMA(0, 1, At, B1); PG8_BAR; PG8_SCHED;
            PG8_LDA(At, 0, 1); PG8_STAGE(PG8_SB(0, 0), b2, voffB); PG8_STAGE(PG8_SB(0, 1), b2 + hstep, voffB); PG8_STAGE(PG8_SA(0, 0), a2, voffA);
            PG8_WAIT_V(8); PG8_WAIT_L(0); PG8_BAR; PG8_MMA(1, 0, At, B0); PG8_MMA(1, 1, At, B1); PG8_BAR; PG8_SCHED;
            PG8_LDB(B0, 1, 0); PG8_LDB(B1, 1, 1); PG8_SCHED; PG8_LDA(At, 1, 0); PG8_STAGE(PG8_SA(0, 1), a2 + hstep, voffA);
            PG8_WAIT_V(8); PG8_WAIT_L(0); PG8_BAR; PG8_MMA(0, 0, At, B0); PG8_MMA(0, 1, At, B1); PG8_BAR; PG8_SCHED;
            PG8_LDA(At, 1, 1); PG8_STAGE(PG8_SB(1, 0), b3, voffB); PG8_STAGE(PG8_SB(1, 1), b3 + hstep, voffB); PG8_STAGE(PG8_SA(1, 0), a3, voffA);
            PG8_WAIT_V(8); PG8_WAIT_L(0); PG8_BAR; PG8_MMA(1, 0, At, B0); PG8_MMA(1, 1, At, B1); PG8_BAR; PG8_SCHED;
            } else {
            PG8_LDB(B0, 0, 0); PG8_SCHED; PG8_LDA(At, 0, 0); PG8_STAGE(PG8_SA(1, 1), a1 + hstep, voffA);
            PG8_WAIT_L(8); PG8_BAR; PG8_WAIT_L(0); PG8_MMA(0, 0, At, B0); PG8_BAR; PG8_SCHED;
            PG8_LDB(B1, 0, 1); PG8_STAGE(PG8_SB(0, 0), b2, voffB);
            PG8_BAR; PG8_WAIT_L(0); PG8_MMA(0, 1, At, B1); PG8_BAR;
            PG8_LDA(At, 0, 1); PG8_STAGE(PG8_SA(0, 0), a2, voffA);
            PG8_BAR; PG8_WAIT_L(0); PG8_MMA(1, 0, At, B0); PG8_BAR; PG8_SCHED;
            PG8_STAGE(PG8_SB(0, 1), b2 + hstep, voffB);
            PG8_WAIT_V(6); PG8_BAR; PG8_MMA(1, 1, At, B1); PG8_BAR;
            PG8_LDB(B0, 1, 0); PG8_SCHED; PG8_LDA(At, 1, 0); PG8_STAGE(PG8_SA(0, 1), a2 + hstep, voffA);
            PG8_WAIT_L(8); PG8_BAR; PG8_WAIT_L(0); PG8_MMA(0, 0, At, B0); PG8_BAR; PG8_SCHED;
            PG8_LDB(B1, 1, 1); PG8_STAGE(PG8_SB(1, 0), b3, voffB);
            PG8_BAR; PG8_WAIT_L(0); PG8_MMA(0, 1, At, B1); PG8_BAR;
            PG8_LDA(At, 1, 1); PG8_STAGE(PG8_SA(1, 0), a3, voffA);
            PG8_BAR; PG8_WAIT_L(0); PG8_MMA(1, 0, At, B0); PG8_BAR; PG8_SCHED;
            PG8_STAGE(PG8_SB(1, 1), b3 + hstep, voffB);
            PG8_WAIT_V(6); PG8_BAR; PG8_MMA(1, 1, At, B1); PG8_BAR;
            }
        }
        if constexpr (ALIGN_EPI) { if (wr == 0) PG8_BAR; }
        if constexpr (!Epi::AFTER_DRAIN) { E(acc, cur, wr, wc, fr, fq); S.done(cur); }
        if (!has_next) break;
#pragma unroll
        for (int a = 0; a < 2; ++a)
#pragma unroll
            for (int b = 0; b < 2; ++b)
#pragma unroll
                for (int m = 0; m < 4; ++m)
#pragma unroll
                    for (int n = 0; n < 2; ++n) acc[a][b][m][n] = (f32x4){0.f, 0.f, 0.f, 0.f};
        cur = nxt; cA = nA; cB = nB; ++ui;
        if constexpr (ALIGN_EPI) { if (wr == 1) PG8_BAR; }
    }
    PG8_WAIT_V(0);
    if constexpr (!ALIGN_EPI) { if (wr == 0) PG8_BAR; }
    PG8_BAR;
    if constexpr (Epi::AFTER_DRAIN) { E.fused(acc, cur, wr, wc, fr, fq, lds, wid, lane); S.done(cur); }
#undef PG8_SA
#undef PG8_SB
#undef PG8_STAGE
#undef PG8_LDA
#undef PG8_LDB
#undef PG8_MMA
#undef PG8_WAIT_V
#undef PG8_WAIT_L
#undef PG8_BAR
#undef PG8_SCHED
}
}

#ifndef PG8_SP2
#define PG8_SP2 true
#endif
#ifndef PG8_ALIGN
#define PG8_ALIGN true
#endif
#define LAS __attribute__((address_space(3)))

__device__ __forceinline__ void transpose_item(const float* W, int K, int N, const float* kg, bf16_t* WT, int k0, int n_src0, int p0, LAS float* scr, int lane) {
#pragma unroll 8
    for (int i = 0; i < 32; ++i) { const int kk = 2 * i + (lane >> 5); float w = W[(size_t)(k0 + kk) * N + n_src0 + (lane & 31)]; if (kg) w *= kg[k0 + kk]; scr[kk * 33 + (lane & 31)] = w; }
    asm volatile("s_waitcnt lgkmcnt(0)" ::: "memory");
    const int c = lane & 7;
#pragma unroll
    for (int j = 0; j < 4; ++j) { const int n = (lane >> 3) + 8 * j; const LAS float* s = scr + (8 * c) * 33 + n;
        u32x4 o; o.x = pk2(s[0 * 33], s[1 * 33]); o.y = pk2(s[2 * 33], s[3 * 33]); o.z = pk2(s[4 * 33], s[5 * 33]); o.w = pk2(s[6 * 33], s[7 * 33]);
        *(u32x4*)(WT + (size_t)(p0 + n) * K + k0 + 8 * c) = o; }
    asm volatile("s_waitcnt lgkmcnt(0)" ::: "memory");
}
__device__ __forceinline__ void convert_weights(LAS unsigned char* lds, const float* w_in, const float* w_out, const float* w_ffn_in, const float* norm_ffn, const float* w_down,
                                                bf16_t* WIN, bf16_t* WOUT, bf16_t* WFI, bf16_t* WFD) {
    int tid_ = threadIdx.x; asm volatile("" : "+v"(tid_));
    const int lane = tid_ & 63, wave = tid_ >> 6;
    LAS float* scr = (LAS float*)(lds + wave * 16384);
    const int gw = blockIdx.x * 8 + wave, NGW = gridDim.x * 8;
    constexpr int I_IN = 16 * 40, I_OUT = 16 * 32, I_FI = 16 * 176, I_FD = 44 * 32;
    for (int it = gw; it < I_IN + I_OUT + I_FI + I_FD; it += NGW) {
        int r = it;
        if (r < I_IN) { const int kb = r / 40, grp = r % 40, pn = grp >> 3, rem = grp & 7, bj = rem >> 2, wc = rem & 3;
            transpose_item(w_in, DM, DIN, nullptr, WIN, kb * 64, 256 * pn + 64 * wc + 32 * bj, 32 * grp, scr, lane); continue; }
        r -= I_IN;
        if (r < I_OUT) { const int kb = r / 32, grp = r % 32; transpose_item(w_out, DM, DM, nullptr, WOUT, kb * 64, 32 * grp, 32 * grp, scr, lane); continue; }
        r -= I_OUT;
        if (r < I_FI) { const int kb = r / 176, grp = r % 176, pn = grp >> 3, rem = grp & 7, bj = rem >> 2, q = rem & 3;
            transpose_item(w_ffn_in, DM, 2 * DFF, norm_ffn, WFI, kb * 64, 128 * pn + 32 * q + bj * DFF, 32 * grp, scr, lane); continue; }
        r -= I_FI;
        { const int kb = r / 32, grp = r % 32; transpose_item(w_down, DFF, DM, nullptr, WFD, kb * 64, 32 * grp, 32 * grp, scr, lane); }
    }
}

struct EpiDownG {
    static constexpr bool PERM = true, AFTER_DRAIN = false;
    float* out; float* ssq;
    __device__ __forceinline__ void operator()(const pg8::f32x4 (&acc)[2][2][4][2], const pg8::Unit& u, int wr, int wc, int fr, int fq) const {
        const int row0 = u.pm * 256 + wr * 64 + fr, col0 = u.pn * 256 + wc * 32 + 8 * fq;
#pragma unroll
        for (int ai = 0; ai < 2; ++ai)
#pragma unroll
            for (int m = 0; m < 4; ++m) {
                const int row = row0 + ai * 128 + m * 16;
                float* rp = out + (size_t)row * DM + col0; float s = 0.f;
#pragma unroll
                for (int bj = 0; bj < 2; ++bj) {
                    f32x4 a = *(const f32x4*)(rp + bj * 128), b = *(const f32x4*)(rp + bj * 128 + 4);
                    a += acc[ai][bj][m][0]; b += acc[ai][bj][m][1];
                    *(f32x4*)(rp + bj * 128) = a; *(f32x4*)(rp + bj * 128 + 4) = b;
                    s += (a.x * a.x + a.y * a.y) + (a.z * a.z + a.w * a.w) + (b.x * b.x + b.y * b.y) + (b.z * b.z + b.w * b.w);
                }
                s += __shfl_xor(s, 16); s += __shfl_xor(s, 32);
                if (fq == 0) ssq[(size_t)row * 16 + u.pn * 4 + wc] = s;
            }
    }
};


typedef unsigned u32x2 __attribute__((ext_vector_type(2)));
struct EpiOutG {
    static constexpr bool PERM = true, AFTER_DRAIN = false;
    const float* x; float* out; bf16_t* A2; float* ssq;
    __device__ __forceinline__ void operator()(const pg8::f32x4 (&acc)[2][2][4][2], const pg8::Unit& u, int wr, int wc, int fr, int fq) const {
        const int row0 = u.pm * 256 + wr * 64 + fr, col0 = u.pn * 256 + wc * 32 + 8 * fq;
#pragma unroll
        for (int ai = 0; ai < 2; ++ai)
#pragma unroll
            for (int m = 0; m < 4; ++m) {
                const int row = row0 + ai * 128 + m * 16;
                const size_t off = (size_t)row * DM + col0; float s = 0.f;
#pragma unroll
                for (int bj = 0; bj < 2; ++bj) {
                    f32x4 a = *(const f32x4*)(x + off + bj * 128), b = *(const f32x4*)(x + off + bj * 128 + 4);
                    a += acc[ai][bj][m][0]; b += acc[ai][bj][m][1];
                    *(f32x4*)(out + off + bj * 128) = a; *(f32x4*)(out + off + bj * 128 + 4) = b;
                    u32x4 w; w.x = pg8::cvt_pk_bf16(a.x, a.y); w.y = pg8::cvt_pk_bf16(a.z, a.w); w.z = pg8::cvt_pk_bf16(b.x, b.y); w.w = pg8::cvt_pk_bf16(b.z, b.w);
                    *(u32x4*)(A2 + off + bj * 128) = w;
                    s += (a.x * a.x + a.y * a.y) + (a.z * a.z + a.w * a.w) + (b.x * b.x + b.y * b.y) + (b.z * b.z + b.w * b.w);
                }
                s += __shfl_xor(s, 16); s += __shfl_xor(s, 32);
                if (fq == 0) ssq[(size_t)row * 16 + u.pn * 4 + wc] = s;
            }
    }
};
__device__ __forceinline__ float silu_mul(float g, float u) { return g * __builtin_amdgcn_rcpf(1.f + __builtin_amdgcn_exp2f(-1.4426950408889634f * g)) * u; }
struct EpiFfnInG {
    static constexpr bool PERM = true, AFTER_DRAIN = false;
    const float* ssq; bf16_t* ACT;
    __device__ __forceinline__ void operator()(const pg8::f32x4 (&acc)[2][2][4][2], const pg8::Unit& u, int wr, int wc, int fr, int fq) const {
        const int row0 = u.pm * 256 + wr * 64 + fr, col0 = u.pn * 128 + wc * 32 + 8 * fq;
#pragma unroll
        for (int ai = 0; ai < 2; ++ai)
#pragma unroll
            for (int m = 0; m < 4; ++m) {
                const int row = row0 + ai * 128 + m * 16;
                const f32x4* sp = (const f32x4*)(ssq + (size_t)row * 16);
                const f32x4 s0 = sp[0], s1 = sp[1], s2 = sp[2], s3 = sp[3];
                const float t = ((s0.x + s0.y) + (s0.z + s0.w)) + ((s1.x + s1.y) + (s1.z + s1.w)) + ((s2.x + s2.y) + (s2.z + s2.w)) + ((s3.x + s3.y) + (s3.z + s3.w));
                const float rs = 1.0f / sqrtf(t * (1.f / DM) + EPS);
                const f32x4 g0 = acc[ai][0][m][0] * rs, g1 = acc[ai][0][m][1] * rs, u0 = acc[ai][1][m][0] * rs, u1 = acc[ai][1][m][1] * rs;
                u32x4 w;
                w.x = pg8::cvt_pk_bf16(silu_mul(g0.x, u0.x), silu_mul(g0.y, u0.y)); w.y = pg8::cvt_pk_bf16(silu_mul(g0.z, u0.z), silu_mul(g0.w, u0.w));
                w.z = pg8::cvt_pk_bf16(silu_mul(g1.x, u1.x), silu_mul(g1.y, u1.y)); w.w = pg8::cvt_pk_bf16(silu_mul(g1.z, u1.z), silu_mul(g1.w, u1.w));
                *(u32x4*)(ACT + (size_t)row * DFF + col0) = w;
            }
    }
};
struct EpiInG {
    static constexpr bool PERM = false, AFTER_DRAIN = false;
    const float* qn; const float* kn; const float* rope; bf16_t* Q; bf16_t* K; bf16_t* V; bf16_t* U;
    __device__ __forceinline__ void operator()(const pg8::f32x4 (&acc)[2][2][4][2], const pg8::Unit& u, int wr, int wc, int fr, int fq) const {
        const int g = 4 * u.pn + wc;
        const int row0 = u.pm * 256 + wr * 64 + fr;
        if (g < 10) {
            const float* gn = g < 8 ? qn : kn;
            f32x4 gv[2][2];
#pragma unroll
            for (int bj = 0; bj < 2; ++bj)
#pragma unroll
                for (int n = 0; n < 2; ++n) gv[bj][n] = *(const f32x4*)(gn + 32 * bj + 16 * n + 4 * fq);
            const float osc = g < 8 ? C2 : 1.f;
            bf16_t* base = g < 8 ? Q + g * 64 : K + (g - 8) * 64; const int pitch = g < 8 ? DATT : DKV;
#pragma unroll
            for (int ai = 0; ai < 2; ++ai)
#pragma unroll
                for (int m = 0; m < 4; ++m) {
                    const int row = row0 + ai * 128 + m * 16;
                    float s = 0.f;
#pragma unroll
                    for (int bj = 0; bj < 2; ++bj)
#pragma unroll
                        for (int n = 0; n < 2; ++n) { const f32x4 v = acc[ai][bj][m][n]; s += (v.x * v.x + v.y * v.y) + (v.z * v.z + v.w * v.w); }
                    s += __shfl_xor(s, 16); s += __shfl_xor(s, 32);
                    const float rn = (1.0f / sqrtf(s * (1.f / 64.f) + EPS));
                    const int sidx = row & (SEQ - 1);
#pragma unroll
                    for (int bj = 0; bj < 2; ++bj) {
                        f32x4 cc = (f32x4){1.f, 1.f, 1.f, 1.f}, ss = (f32x4){0.f, 0.f, 0.f, 0.f};
                        if (row < MR) {
                            const int ci = bj == 0 ? (sidx >> 6) : (sidx & 63);
                            const f32x4* tp = (const f32x4*)(rope + (ci * 16 + 4 * fq) * 2);
                            const f32x4 t0 = tp[0], t1 = tp[1];
                            cc = (f32x4){t0.x, t0.z, t1.x, t1.z}; ss = (f32x4){t0.y, t0.w, t1.y, t1.w};
                        }
                        const f32x4 x0 = acc[ai][bj][m][0] * rn * gv[bj][0], x1 = acc[ai][bj][m][1] * rn * gv[bj][1];
                        const f32x4 o0 = (x0 * cc - x1 * ss) * osc, o1 = (x0 * ss + x1 * cc) * osc;
                        bf16_t* p = base + (size_t)row * pitch + 32 * bj + 4 * fq;
                        u32x2 w0, w1; w0.x = pg8::cvt_pk_bf16(o0.x, o0.y); w0.y = pg8::cvt_pk_bf16(o0.z, o0.w); w1.x = pg8::cvt_pk_bf16(o1.x, o1.y); w1.y = pg8::cvt_pk_bf16(o1.z, o1.w);
                        *(u32x2*)p = w0; *(u32x2*)(p + 16) = w1;
                    }
                }
        } else {
            bf16_t* base = g < 12 ? V + (g - 10) * 64 : U + (g - 12) * 64; const int pitch = g < 12 ? DKV : DPOOL;
#pragma unroll
            for (int ai = 0; ai < 2; ++ai)
#pragma unroll
                for (int m = 0; m < 4; ++m) {
                    const int row = row0 + ai * 128 + m * 16;
#pragma unroll
                    for (int bj = 0; bj < 2; ++bj)
#pragma unroll
                        for (int n = 0; n < 2; ++n) { const f32x4 v = acc[ai][bj][m][n]; u32x2 w; w.x = pg8::cvt_pk_bf16(v.x, v.y); w.y = pg8::cvt_pk_bf16(v.z, v.w);
                            *(u32x2*)(base + (size_t)row * pitch + 32 * bj + 16 * n + 4 * fq) = w; }
                }
        }
    }
};

__device__ __forceinline__ void rope_table(float* tab) {
    for (int idx = blockIdx.x * NTHREADS + threadIdx.x; idx < 64 * 16; idx += gridDim.x * NTHREADS) {
        const int ci = idx >> 4, i = idx & 15;
        const int lo = i & 3, hi = i >> 2;
        double f = lo == 0 ? 1.0 : lo == 1 ? 0.5623413251903491 : lo == 2 ? 0.31622776601683794 : 0.1778279410038923;
        f *= hi == 0 ? 1.0 : hi == 1 ? 0.1 : hi == 2 ? 0.01 : 0.001;
        const float ang_f = (float)(ci - 32) * (float)f;
        double a = (double)ang_f;
        a -= 6.283185307179586 * __builtin_rint(a * 0.15915494309189535);
        const double a2 = a * a;
        double sn = a, cs = 1.0, ts = a, tc = 1.0;
        for (int k = 1; k <= 16; ++k) {
            tc *= -a2 / (double)((2 * k - 1) * (2 * k));
            ts *= -a2 / (double)((2 * k) * (2 * k + 1));
            cs += tc; sn += ts;
        }
        tab[2 * idx] = (float)cs; tab[2 * idx + 1] = (float)sn;
    }
}
__device__ __forceinline__ void rms_rows_p0(const float* x, const float* meta, const float* g, bf16_t* HN) {
    int tid_ = threadIdx.x; asm volatile("" : "+v"(tid_));
    const int lane = tid_ & 63, gw = blockIdx.x * 8 + (tid_ >> 6), NGW = gridDim.x * 8;
    f32x4 gv[4];
#pragma unroll
    for (int j = 0; j < 4; ++j) gv[j] = *((const f32x4*)g + lane + 64 * j);
    for (int m = gw; m < MP; m += NGW) {
        unsigned long long* o8 = (unsigned long long*)(HN + (size_t)m * DM) + lane;
        if (m >= MR + NMETA) {
#pragma unroll
            for (int j = 0; j < 4; ++j) o8[64 * j] = 0ull;
            continue;
        }
        const float* src = m < MR ? x + (size_t)m * DM : meta + (size_t)(m - MR) * DM;
        const f32x4* xr = (const f32x4*)src + lane;
        f32x4 v[4]; float s = 0.f;
#pragma unroll
        for (int j = 0; j < 4; ++j) { v[j] = xr[64 * j]; s += (v[j].x * v[j].x + v[j].y * v[j].y) + (v[j].z * v[j].z + v[j].w * v[j].w); }
        const float rs = 1.0f / sqrtf(wave_sum(s) * (1.f / DM) + EPS);
#pragma unroll
        for (int j = 0; j < 4; ++j) {
            const f32x4 y = v[j] * rs * gv[j];
            o8[64 * j] = (unsigned long long)pk2(y.x, y.y) | ((unsigned long long)pk2(y.z, y.w) << 32);
        }
    }
}

#include <hip/hip_bf16.h>
#include <cmath>
namespace attn_body {
using bf16=__hip_bfloat16;
using bf16x8=__attribute__((ext_vector_type(8)))short;
using s16x4=__attribute__((ext_vector_type(4)))short;
using f32x16=__attribute__((ext_vector_type(16)))float;
using u32x4=__attribute__((ext_vector_type(4)))unsigned;
using f32x4v=__attribute__((ext_vector_type(4)))float;
constexpr int D=64,QP=512,KP=128;
constexpr int NW=8,QBLK=32,KVBLK=64,NT=65,NREAL=64;
__device__ __forceinline__ int crow(int r,int hi){return (r&3)+8*(r>>2)+4*hi;}
#define SBAR() __builtin_amdgcn_sched_barrier(0)
__device__ __forceinline__ void mmask(f32x16&p0,f32x16&p1){
  const float NEG=-INFINITY;
  #pragma unroll
  for(int r=8;r<16;++r)p0[r]=NEG;
  #pragma unroll
  for(int r=0;r<16;++r)p1[r]=NEG;
}

constexpr int NSLOT=3, SLOTB=8192;
constexpr int OB_PITCH=1040;
constexpr int LDS_K=0, LDS_V=NSLOT*SLOTB, LDS_WS=2*NSLOT*SLOTB, LDS_OB=LDS_WS+NW*64*4, LDS_BYTES=LDS_OB+64*OB_PITCH;
constexpr float C2=0.125f*1.4426950408889634f;
__device__ __forceinline__ void glds16(const void*gsrc,unsigned lds_dst){unsigned keep;
  asm volatile("s_mov_b32 %0, m0\n\ts_mov_b32 m0, %2\n\ts_nop 0\n\tglobal_load_lds_dwordx4 %1, off\n\ts_mov_b32 m0, %0":"=&s"(keep):"v"(gsrc),"s"(lds_dst):"memory");}
__device__ __forceinline__ float max3f(float a,float b,float c){float r;asm("v_max3_f32 %0, %1, %2, %3":"=v"(r):"v"(a),"v"(b),"v"(c));return r;}
__device__ __forceinline__ float max2f(float a,float b){float r;asm("v_max_f32_e32 %0, %1, %2":"=v"(r):"v"(a),"v"(b));return r;}
__device__ __forceinline__ float fadd_s(float a,float b){float r;asm("v_add_f32_e32 %0, %1, %2":"=v"(r):"v"(a),"v"(b));return r;}
__device__ __forceinline__ float fsub_s(float a,float b){float r;asm("v_sub_f32_e32 %0, %1, %2":"=v"(r):"v"(a),"v"(b));return r;}
typedef float f32x2_t __attribute__((ext_vector_type(2))); typedef __bf16 bf16x2_t __attribute__((ext_vector_type(2)));
__device__ __forceinline__ unsigned cvtpk_s(float lo,float hi){f32x2_t v={lo,hi};bf16x2_t b=__builtin_convertvector(v,bf16x2_t);return __builtin_bit_cast(unsigned,b);}
#define WAIT_BAR(N) asm volatile("s_waitcnt vmcnt(" #N ") lgkmcnt(0)\n\ts_barrier":::"memory")

__device__ __forceinline__ void qkt(f32x16&p0,f32x16&p1,const char*Kslot,const bf16x8*qr,const f32x16&negm,int r32,int hi){
  const char*kb=Kslot+hi*1024+r32*16;
  #pragma unroll
  for(int d0=0;d0<4;++d0){
    const bf16x8 b0=*reinterpret_cast<const bf16x8*>(kb+d0*2048);
    const bf16x8 b1=*reinterpret_cast<const bf16x8*>(kb+d0*2048+512);
    if(d0==0){p0=__builtin_amdgcn_mfma_f32_32x32x16_bf16(b0,qr[0],negm,0,0,0);p1=__builtin_amdgcn_mfma_f32_32x32x16_bf16(b1,qr[0],negm,0,0,0);}
    else{p0=__builtin_amdgcn_mfma_f32_32x32x16_bf16(b0,qr[d0],p0,0,0,0);p1=__builtin_amdgcn_mfma_f32_32x32x16_bf16(b1,qr[d0],p1,0,0,0);}}
}
typedef __attribute__((address_space(3))) const char* lds_cptr;
typedef short v4i16_t __attribute__((ext_vector_type(4)));
__device__ __forceinline__ void kload8(bf16x8*kf,lds_cptr kp){
  kf[0]=*(const __attribute__((address_space(3))) bf16x8*)(kp);      kf[1]=*(const __attribute__((address_space(3))) bf16x8*)(kp+512);
  kf[2]=*(const __attribute__((address_space(3))) bf16x8*)(kp+2048); kf[3]=*(const __attribute__((address_space(3))) bf16x8*)(kp+2560);
  kf[4]=*(const __attribute__((address_space(3))) bf16x8*)(kp+4096); kf[5]=*(const __attribute__((address_space(3))) bf16x8*)(kp+4608);
  kf[6]=*(const __attribute__((address_space(3))) bf16x8*)(kp+6144); kf[7]=*(const __attribute__((address_space(3))) bf16x8*)(kp+6656);
}
__device__ __forceinline__ void kload2(bf16x8*kf,lds_cptr kp,int j){ kf[2*j]=*(const __attribute__((address_space(3))) bf16x8*)(kp+j*2048); kf[2*j+1]=*(const __attribute__((address_space(3))) bf16x8*)(kp+j*2048+512); }
__device__ __forceinline__ s16x4 vtr(lds_cptr p){ return __builtin_bit_cast(s16x4,__builtin_amdgcn_ds_read_tr16_b64_v4i16((__attribute__((address_space(3))) v4i16_t*)p)); }
__device__ __forceinline__ float rowmax(const f32x16&p0,const f32x16&p1){
  float a=max3f(p0[0],p0[1],p1[0]),b=max3f(p0[2],p0[3],p1[1]);a=max3f(a,p1[2],p1[3]);
  #pragma unroll
  for(int r=4;r<16;r+=4){a=max3f(a,p0[r],p0[r+1]);b=max3f(b,p0[r+2],p0[r+3]);a=max3f(a,p1[r],p1[r+1]);b=max3f(b,p1[r+2],p1[r+3]);}
  const float m=max2f(a,b);
  auto rr=__builtin_amdgcn_permlane32_swap(__float_as_uint(m),__float_as_uint(m),false,false);
  return max2f(__uint_as_float(rr[0]),__uint_as_float(rr[1]));
}
__device__ __forceinline__ void pv(f32x16*o,int vb,bf16x8 pa0,bf16x8 pa1,bf16x8 pa2,bf16x8 pa3){
  #pragma unroll
  for(int d0=0;d0<2;++d0){s16x4 lo[4],hi[4];
    #pragma unroll
    for(int ks=0;ks<4;++ks){
      asm volatile("ds_read_b64_tr_b16 %0,%1 offset:%c2":"=&v"(lo[ks]):"v"(vb),"i"(d0*4096+ks*1024):"memory");
      asm volatile("ds_read_b64_tr_b16 %0,%1 offset:%c2":"=&v"(hi[ks]):"v"(vb),"i"(d0*4096+ks*1024+512):"memory");}
    asm volatile("s_waitcnt lgkmcnt(0)":::"memory");SBAR();
    #define PK(k) (bf16x8){lo[k][0],lo[k][1],lo[k][2],lo[k][3],hi[k][0],hi[k][1],hi[k][2],hi[k][3]}
    o[d0]=__builtin_amdgcn_mfma_f32_32x32x16_bf16(pa0,PK(0),o[d0],0,0,0);
    o[d0]=__builtin_amdgcn_mfma_f32_32x32x16_bf16(pa1,PK(1),o[d0],0,0,0);
    o[d0]=__builtin_amdgcn_mfma_f32_32x32x16_bf16(pa2,PK(2),o[d0],0,0,0);
    o[d0]=__builtin_amdgcn_mfma_f32_32x32x16_bf16(pa3,PK(3),o[d0],0,0,0);
    #undef PK
  }
}

#ifndef ATTN_STORE16
#define ATTN_STORE16(p,v) (*(u32x4*)(p)=(v))
#endif
template<int THRL> __device__ __forceinline__ void attn_unit(int b,int kvh,int rb,const bf16*Q,const bf16*__restrict__ K,const bf16*__restrict__ V,char*shm){
  int tid_=threadIdx.x; asm volatile("":"+v"(tid_));
  const int tid=tid_,lane=tid&63,r32=lane&31,hi=lane>>5; const int wid=__builtin_amdgcn_readfirstlane(tid>>6);
  const long rowbase=(long)b*4096; const int q0=rb*64; const int h=kvh*4+(wid>>1);
  const bf16*Qw=Q+(rowbase+q0+(wid&1)*QBLK)*QP+h*D;
  const bf16*Kh=K+rowbase*KP+kvh*D,*Vh=V+rowbase*KP+kvh*D;
  const long metaoff=((long)32768-rowbase)*KP;
  const unsigned lds0=(unsigned)(uintptr_t)shm;
  float*wsf=(float*)(shm+LDS_WS)+wid*64;
  const bf16*ksrc=Kh+(long)lane*KP+wid*8;
  const bf16*vsrc=Vh+(long)(16*(wid&3)+(lane>>2))*KP+(wid>>2)*32+(lane&3)*8;
  const unsigned kdst=lds0+LDS_K+wid*1024, vdst=lds0+LDS_V+wid*1024;
  #define DMA_K(t,slot) glds16(ksrc+((t)<NREAL?(long)(t)*KVBLK*KP:metaoff),(unsigned)__builtin_amdgcn_readfirstlane(kdst+(slot)))
  #define DMA_V(t,slot) glds16(vsrc+((t)<NREAL?(long)(t)*KVBLK*KP:metaoff),(unsigned)__builtin_amdgcn_readfirstlane(vdst+(slot)))
  const int vb0=(int)(lds0+LDS_V)+((lane>>4)&1)*32+(lane&3)*8+(4*hi+((lane&15)>>2))*64;
  const char*Kbase=shm+LDS_K; bf16x8 kf[8];
  const lds_cptr shm3=(lds_cptr)shm; const lds_cptr kp0=shm3+LDS_K+hi*1024+r32*16; const lds_cptr vp0=shm3+LDS_V+((lane>>4)&1)*32+(lane&3)*8+(4*hi+((lane&15)>>2))*64;
  DMA_K(0,0);DMA_V(0,0);DMA_K(1,SLOTB);
  bf16x8 qr[4];
  #pragma unroll
  for(int d0=0;d0<4;++d0)qr[d0]=*reinterpret_cast<const bf16x8*>(&Qw[(long)r32*QP+d0*16+hi*8]);
  float mhat=0.f,l_reg=0.f;f32x16 o[2];o[0]=f32x16{};o[1]=f32x16{};f32x16 negm=f32x16{};asm volatile("":"+v"(negm));
  #define CMASK(P0,P1,t) do{ if((t)==NT-1)mmask(P0,P1); }while(0)
  bool resc=false;
  #define START(P0,P1) do{ const float rm=rowmax(P0,P1); resc=false; \
    { const float dl=rm; mhat=fadd_s(mhat,dl); \
      _Pragma("unroll") for(int r=0;r<16;++r){P0[r]=fsub_s(P0[r],dl);P1[r]=fsub_s(P1[r],dl);} \
      _Pragma("unroll") for(int r=0;r<16;++r)negm[r]=-mhat; asm volatile("":"+v"(negm)); } \
    _Pragma("unroll") for(int r=0;r<16;++r)P0[r]=__builtin_amdgcn_exp2f(P0[r]); }while(0)
  #define RESC() do{ if(resc){ asm volatile("s_waitcnt lgkmcnt(0)":::"memory"); \
      _Pragma("unroll") for(int d_=0;d_<2;++d_) _Pragma("unroll") for(int r=0;r<16;++r)o[d_][r]*=wsf[crow(r,hi)]; } }while(0)
  f32x16 pA0,pA1,pB0,pB1;
  int sl_prev=0,sl_cur=0,sl_next=SLOTB;
  #define ROT() do{sl_prev=sl_cur;sl_cur=sl_next;sl_next=(sl_next==(NSLOT-1)*SLOTB)?0:sl_next+SLOTB;}while(0)
  DMA_K(2,2*SLOTB);
  WAIT_BAR(3);
  qkt(pA0,pA1,Kbase,qr,negm,r32,hi);asm volatile("s_nop 15\n\ts_nop 7":"+v"(pA0),"+v"(pA1));CMASK(pA0,pA1,0);
  START(pA0,pA1);
  _Pragma("unroll") for(int r=0;r<16;++r)pA1[r]=__builtin_amdgcn_exp2f(pA1[r]);
  WAIT_BAR(0);
  DMA_K(3,0);DMA_V(1,SLOTB);
  ROT();
  kload8(kf,kp0+sl_cur);
  WAIT_BAR(2);
  s16x4 vlo[8],vhi[8]; u32x4 pw0,pw1,pw2,pw3;
  #define PKW(P,B) cvtpk_s(P[B],P[B+1])
  #define PAF(k) __builtin_bit_cast(bf16x8,pw##k)
  #define VFR(i) (bf16x8){vlo[i][0],vlo[i][1],vlo[i][2],vlo[i][3],vhi[i][0],vhi[i][1],vhi[i][2],vhi[i][3]}
  #define PIN(x) asm volatile("":"+v"(x))
  #define MX3(a,b,c) __builtin_fmaxf(__builtin_fmaxf((a),(b)),(c))
  #define GAPA(MF,A0,A1,A2,A3,W0,W1,PW) do{ MF; sacc+=A0; sacc+=A1; sacc+=A2; sacc+=A3; PIN(sacc); W0; W1; PIN(PW); SBAR(); }while(0)
  #define EX(v) __builtin_amdgcn_exp2f(v)
  #define GAPB(MF,X,B) do{ MF; X[B]=EX(X[B]); X[B+1]=EX(X[B+1]); X[B+2]=EX(X[B+2]); X[B+3]=EX(X[B+3]); PIN(X); SBAR(); }while(0)
  #define VRD(i) do{ vlo[i]=vtr(vp_+(((i)>>2)*4096+((i)&3)*1024)); vhi[i]=vtr(vp_+(((i)>>2)*4096+((i)&3)*1024+512)); }while(0)
  #define KRD(G,j) do{ if(G){ kload2(kf,kp0+sl_next,j); SBAR(); } }while(0)
  #define STEP(C0,C1,P0,P1,t,GK,GV,GL) do{ SBAR(); \
    const lds_cptr vp_=vp0+sl_prev; \
    VRD(0); SBAR(); float sacc=(P0[0]+P0[1]); \
    GAPA(C0=__builtin_amdgcn_mfma_f32_32x32x16_bf16(kf[0],qr[0],negm,0,0,0), P0[2],P0[3],P0[4],P0[5],     pw0[0]=PKW(P0,0), pw0[1]=PKW(P0,2), pw0); \
    VRD(4); SBAR(); GAPA(C1=__builtin_amdgcn_mfma_f32_32x32x16_bf16(kf[1],qr[0],negm,0,0,0), P0[6],P0[7],P0[8],P0[9],     pw0[2]=PKW(P0,4), pw0[3]=PKW(P0,6), pw0); \
    VRD(1); SBAR(); GAPA(C0=__builtin_amdgcn_mfma_f32_32x32x16_bf16(kf[2],qr[1],C0,0,0,0),   P0[10],P0[11],P0[12],P0[13], pw1[0]=PKW(P0,8), pw1[1]=PKW(P0,10), pw1); \
    VRD(5); SBAR(); GAPA(C1=__builtin_amdgcn_mfma_f32_32x32x16_bf16(kf[3],qr[1],C1,0,0,0),   P0[14],P0[15],P1[0],P1[1],   pw1[2]=PKW(P0,12),pw1[3]=PKW(P0,14), pw1); \
    VRD(2); SBAR(); GAPA(C0=__builtin_amdgcn_mfma_f32_32x32x16_bf16(kf[4],qr[2],C0,0,0,0),   P1[2],P1[3],P1[4],P1[5],     pw2[0]=PKW(P1,0), pw2[1]=PKW(P1,2), pw2); \
    VRD(6); SBAR(); GAPA(C1=__builtin_amdgcn_mfma_f32_32x32x16_bf16(kf[5],qr[2],C1,0,0,0),   P1[6],P1[7],P1[8],P1[9],     pw2[2]=PKW(P1,4), pw2[3]=PKW(P1,6), pw2); \
    VRD(3); SBAR(); GAPA(C0=__builtin_amdgcn_mfma_f32_32x32x16_bf16(kf[6],qr[3],C0,0,0,0),   P1[10],P1[11],P1[12],P1[13], pw3[0]=PKW(P1,8), pw3[1]=PKW(P1,10), pw3); \
    VRD(7); SBAR(); GAPA(C1=__builtin_amdgcn_mfma_f32_32x32x16_bf16(kf[7],qr[3],C1,0,0,0),   P1[14],P1[15],0.f,0.f,       pw3[2]=PKW(P1,12),pw3[3]=PKW(P1,14), pw3); \
    l_reg+=sacc; \
    if(GK){DMA_K((t)+3,sl_cur);} if(GV){DMA_V((t)+1,sl_next);} \
    CMASK(C0,C1,t); \
    { float a=MX3(C0[0],C0[1],C1[0]),b=MX3(C0[2],C0[3],C1[1]); a=MX3(a,C1[2],C1[3]); \
      _Pragma("unroll") for(int r=4;r<16;r+=4){a=MX3(a,C0[r],C0[r+1]);b=MX3(b,C0[r+2],C0[r+3]);a=MX3(a,C1[r],C1[r+1]);b=MX3(b,C1[r+2],C1[r+3]);} \
      float rm=__builtin_fmaxf(a,b); { auto rr=__builtin_amdgcn_permlane32_swap(__float_as_uint(rm),__float_as_uint(rm),false,false); rm=__builtin_fmaxf(__uint_as_float(rr[0]),__uint_as_float(rr[1])); } \
      resc=false; \
      if(__builtin_expect(__any(rm>(float)THRL),0)){ const float dl=__builtin_fmaxf(rm,0.f); mhat+=dl; \
        _Pragma("unroll") for(int r=0;r<16;++r){C0[r]-=dl;C1[r]-=dl;} \
        _Pragma("unroll") for(int r=0;r<16;++r)negm[r]=-mhat; asm volatile("":"+v"(negm)); \
        const float f=__builtin_amdgcn_exp2f(-dl); l_reg*=f; if(hi==0)wsf[r32]=f; resc=true; } } \
    SBAR(); \
    GAPB(o[0]=__builtin_amdgcn_mfma_f32_32x32x16_bf16(PAF(0),VFR(0),o[0],0,0,0), C0,0); \
    GAPB(o[1]=__builtin_amdgcn_mfma_f32_32x32x16_bf16(PAF(0),VFR(4),o[1],0,0,0), C0,4); \
    KRD(GL,0); GAPB(o[0]=__builtin_amdgcn_mfma_f32_32x32x16_bf16(PAF(1),VFR(1),o[0],0,0,0), C0,8); \
    KRD(GL,1); GAPB(o[1]=__builtin_amdgcn_mfma_f32_32x32x16_bf16(PAF(1),VFR(5),o[1],0,0,0), C0,12); \
    KRD(GL,2); GAPB(o[0]=__builtin_amdgcn_mfma_f32_32x32x16_bf16(PAF(2),VFR(2),o[0],0,0,0), C1,0); \
    KRD(GL,3); GAPB(o[1]=__builtin_amdgcn_mfma_f32_32x32x16_bf16(PAF(2),VFR(6),o[1],0,0,0), C1,4); \
    GAPB(o[0]=__builtin_amdgcn_mfma_f32_32x32x16_bf16(PAF(3),VFR(3),o[0],0,0,0), C1,8); \
    GAPB(o[1]=__builtin_amdgcn_mfma_f32_32x32x16_bf16(PAF(3),VFR(7),o[1],0,0,0), C1,12); \
    }while(0)
  int t=1;
  #undef CMASK
  #define CMASK(P0,P1,t) do{}while(0)
  for(;t+5<NT;t+=2){
    STEP(pB0,pB1,pA0,pA1,t,true,true,true);     WAIT_BAR(2); RESC(); ROT();
    STEP(pA0,pA1,pB0,pB1,t+1,true,true,true);   WAIT_BAR(2); RESC(); ROT();
  }
  #undef CMASK
  #define CMASK(P0,P1,t) do{ if((t)==NT-1)mmask(P0,P1); }while(0)
  #define ENDW(tt) do{ if((tt)+3<NT){WAIT_BAR(2);} else if((tt)+2<NT){WAIT_BAR(1);} else {WAIT_BAR(0);} }while(0)
  for(;t+2<NT;t+=2){
    STEP(pB0,pB1,pA0,pA1,t,(t+3<NT),(t+1<NT),(t+1<NT));       ENDW(t);   RESC(); ROT();
    STEP(pA0,pA1,pB0,pB1,t+1,(t+4<NT),(t+2<NT),(t+2<NT));     ENDW(t+1); RESC(); ROT();
  }
  STEP(pB0,pB1,pA0,pA1,NT-2,false,true,true); WAIT_BAR(0); RESC(); ROT();
  STEP(pA0,pA1,pB0,pB1,NT-1,false,false,false); RESC();
  { float sacc=pA0[0]+pA0[1]; _Pragma("unroll") for(int r=2;r<16;++r)sacc+=pA0[r]; _Pragma("unroll") for(int r=0;r<16;++r)sacc+=pA1[r]; l_reg+=sacc;
    pw0=(u32x4){PKW(pA0,0),PKW(pA0,2),PKW(pA0,4),PKW(pA0,6)};pw1=(u32x4){PKW(pA0,8),PKW(pA0,10),PKW(pA0,12),PKW(pA0,14)};pw2=(u32x4){PKW(pA1,0),PKW(pA1,2),PKW(pA1,4),PKW(pA1,6)};pw3=(u32x4){PKW(pA1,8),PKW(pA1,10),PKW(pA1,12),PKW(pA1,14)};
    SBAR(); pv(o,vb0+sl_cur,PAF(0),PAF(1),PAF(2),PAF(3)); }
  #undef PKW
  #undef PAF
  #undef VFR
  #undef PIN
  #undef MX3
  #undef GAPA
  #undef GAPB
  #undef EX
  #undef VRD
  #undef KRD
  #undef STEP
  #undef ENDW
  {auto rr=__builtin_amdgcn_permlane32_swap(__float_as_uint(l_reg),__float_as_uint(l_reg),false,false);l_reg=__uint_as_float(rr[0])+__uint_as_float(rr[1]);}
  if(hi==0)wsf[32+r32]=l_reg;asm volatile("s_waitcnt lgkmcnt(0)":::"memory");
  float rli[16];
  #pragma unroll
  for(int r=0;r<16;++r)rli[r]=__builtin_amdgcn_rcpf(wsf[32+crow(r,hi)]);
  { char*ob=shm+LDS_OB+((wid&1)*QBLK)*OB_PITCH+h*128;
    #pragma unroll
    for(int r=0;r<16;++r){const int orow=crow(r,hi);
      #pragma unroll
      for(int d0=0;d0<2;++d0)*(bf16*)(ob+orow*OB_PITCH+(d0*32+r32)*2)=__float2bfloat16(o[d0][r]*rli[r]);} }
  asm volatile("s_waitcnt lgkmcnt(0)\n\ts_barrier":::"memory");
  #undef DMA_K
  #undef DMA_V
  #undef CMASK
  #undef START
  #undef RESC
  #undef ROT
}
constexpr int ATTN_LDS_BYTES=LDS_BYTES;
__device__ __forceinline__ void attn_rows_out(long m0,const float*gain,unsigned short*MIX,char*shm){
  int tid_=threadIdx.x; asm volatile("":"+v"(tid_));
  const int tid=tid_,lane=tid&63; const int wid=__builtin_amdgcn_readfirstlane(tid>>6);
  const f32x4v g0=*(const f32x4v*)(gain+lane*8),g1=*(const f32x4v*)(gain+lane*8+4);
  #pragma unroll
  for(int i=0;i<8;++i){ const int row=wid*8+i;
    const u32x4 v=*(const u32x4*)(shm+LDS_OB+row*OB_PITCH+lane*16);
    float f[8]; f[0]=__uint_as_float(v[0]<<16);f[1]=__uint_as_float(v[0]&0xffff0000u);f[2]=__uint_as_float(v[1]<<16);f[3]=__uint_as_float(v[1]&0xffff0000u);
    f[4]=__uint_as_float(v[2]<<16);f[5]=__uint_as_float(v[2]&0xffff0000u);f[6]=__uint_as_float(v[3]<<16);f[7]=__uint_as_float(v[3]&0xffff0000u);
    float ss=0.f;
    #pragma unroll
    for(int j=0;j<8;++j)ss+=f[j]*f[j];
    #pragma unroll
    for(int o_=1;o_<64;o_<<=1)ss+=__shfl_xor(ss,o_);
    const float rs=1.0f/sqrtf(ss*(1.f/512.f)+1e-6f);
    u32x4 w; w[0]=cvtpk_s(f[0]*rs*g0[0],f[1]*rs*g0[1]); w[1]=cvtpk_s(f[2]*rs*g0[2],f[3]*rs*g0[3]); w[2]=cvtpk_s(f[4]*rs*g1[0],f[5]*rs*g1[1]); w[3]=cvtpk_s(f[6]*rs*g1[2],f[7]*rs*g1[3]);
    *(u32x4*)(MIX+(m0+row)*1024+lane*8)=w; }
  asm volatile("s_waitcnt lgkmcnt(0)\n\ts_barrier":::"memory");
}
template<int THRL=8> __device__ __forceinline__ void attn_phase(char*lds,const bf16*Q,const bf16*K,const bf16*V,const float*gain,unsigned short*MIX,int vcu,int ncu){
  for(int blk=vcu;blk<512;blk+=ncu){ const int b=blk>>6, rb=blk&63;
    attn_unit<THRL>(b,0,rb,Q,K,V,lds); attn_unit<THRL>(b,1,rb,Q,K,V,lds);
    attn_rows_out((long)b*4096+rb*64,gain,MIX,lds); }
}
#undef SBAR
#undef WAIT_BAR
}

__device__ __forceinline__ void pool_phase(float* lds, const bf16_t* U, const float* wpool, const float* pscale, bf16_t* MIX) {
    int tid_ = threadIdx.x; asm volatile("" : "+v"(tid_));
    const int tid = tid_, wid = tid >> 6, lane = tid & 63;
    float* dl = lds;
    float* red = lds + 16 * 512;
    const int g = tid >> 7, dch = tid & 127;
    const int w2 = 1 << g;
    for (int blk = blockIdx.x; blk < MR / 16; blk += gridDim.x) {
        const int m0 = blk * 16;
        __syncthreads();
        for (int t = 0; t < 16; ++t) {
            const int m = m0 + t, b = m >> 12, s = m & (SEQ - 1);
            const int lo = s - w2;
            const int hi = (s + w2 < SEQ) ? s + w2 : SEQ;
            float sum = 0.f;
            for (int r = lo; r < hi; ++r) {
                const int row = r >= 0 ? b * SEQ + r : MR + NMETA + r;
                sum += bf2f(U[(size_t)row * DPOOL + tid]);
            }
            const float self = bf2f(U[(size_t)m * DPOOL + tid]);
            dl[t * 512 + tid] = sum / (float)(hi - lo) - self;
        }
        __syncthreads();
        float acc[16];
#pragma unroll
        for (int t = 0; t < 16; ++t) acc[t] = 0.f;
        const float* wp = wpool + (size_t)g * 128 * 128 + dch;
        for (int c4 = 0; c4 < 32; ++c4) {
            float w[4];
#pragma unroll
            for (int i = 0; i < 4; ++i) w[i] = wp[(size_t)(4 * c4 + i) * 128];
#pragma unroll
            for (int t = 0; t < 16; ++t) {
                const f32x4 a = *(const f32x4*)&dl[t * 512 + g * 128 + 4 * c4];
                acc[t] += a.x * w[0] + a.y * w[1] + a.z * w[2] + a.w * w[3];
            }
        }
#pragma unroll
        for (int t = 0; t < 16; ++t) { const float s = wave_sum(acc[t] * acc[t]); if (lane == 0) red[t * 8 + wid] = s; }
        __syncthreads();
        const float ps = pscale[tid];
#pragma unroll
        for (int t = 0; t < 16; ++t) {
            float tot = 0.f;
#pragma unroll
            for (int i = 0; i < 8; ++i) tot += red[t * 8 + i];
            const float rs = 1.0f / sqrtf(tot * (1.f / DPOOL) + EPS);
            MIX[(size_t)(m0 + t) * DM + DATT + tid] = (bf16_t)f2bf(acc[t] * rs * ps);
        }
    }
}

__device__ __forceinline__ void final_norm(float* out, const float* ssq, const float* g) {
    int tid_ = threadIdx.x; asm volatile("" : "+v"(tid_));
    const int lane = tid_ & 63, gw = blockIdx.x * 8 + (tid_ >> 6), NGW = gridDim.x * 8;
    f32x4 gv[4];
#pragma unroll
    for (int j = 0; j < 4; ++j) gv[j] = *((const f32x4*)g + lane + 64 * j);
    for (int m = gw; m < MR; m += NGW) {
        float t = 0.f;
#pragma unroll
        for (int i = 0; i < 16; ++i) t += ssq[(size_t)m * 16 + i];
        const float rs = 1.0f / sqrtf(t * (1.f / DM) + EPS);
        f32x4* xr = (f32x4*)(out + (size_t)m * DM) + lane;
#pragma unroll
        for (int j = 0; j < 4; ++j) xr[64 * j] = xr[64 * j] * rs * gv[j];
    }
}

__global__ void __launch_bounds__(NTHREADS, 2) fwd_kernel(Args args) {
    extern __shared__ __attribute__((aligned(16))) unsigned char lds_raw[];
    float* lds = (float*)lds_raw;
    cg::grid_group grid = cg::this_grid();
    unsigned char* ws = args.ws;
    const float* x = args.in[0]; const float* meta = args.in[1]; const float* norm_mix = args.in[2]; const float* w_in = args.in[3];
    const float* q_norm = args.in[4]; const float* k_norm = args.in[5]; const float* attn_out_norm = args.in[6]; const float* w_pool = args.in[7];
    const float* pool_scale = args.in[8]; const float* w_out = args.in[9]; const float* norm_ffn = args.in[10]; const float* w_ffn_in = args.in[11];
    const float* w_ffn_down = args.in[12]; const float* norm_final = args.in[13];
    float* rope = (float*)(ws + WS_ROPE);
    bf16_t* HN = (bf16_t*)(ws + WS_HN); bf16_t* Q = (bf16_t*)(ws + WS_Q); bf16_t* K = (bf16_t*)(ws + WS_K); bf16_t* V = (bf16_t*)(ws + WS_V);
    bf16_t* U = (bf16_t*)(ws + WS_U); bf16_t* MIX = (bf16_t*)(ws + WS_MIX); bf16_t* A2 = (bf16_t*)(ws + WS_A2); bf16_t* ACT = (bf16_t*)(ws + WS_ACT);
    float* SSQ2 = (float*)(ws + WS_SSQ2); float* SSQ3 = (float*)(ws + WS_SSQ3);

    bf16_t* WIN = (bf16_t*)(ws + WS_WIN); bf16_t* WOUT = (bf16_t*)(ws + WS_WOUT); bf16_t* WFI = (bf16_t*)(ws + WS_WFI); bf16_t* WFD = (bf16_t*)(ws + WS_WFD);
    LAS unsigned char* ldsl = (LAS unsigned char*)lds_raw;
    rope_table(rope);
    convert_weights(ldsl, w_in, w_out, w_ffn_in, norm_ffn, w_ffn_down, WIN, WOUT, WFI, WFD);
    rms_rows_p0(x, meta, norm_mix, HN);
    grid.sync();
    { pg8::Gemm g{HN, WIN, MP, DIN, DM}; pg8::StaticOrder S; S.init(MP, DIN, (int)gridDim.x, (int)blockIdx.x); EpiInG e{q_norm, k_norm, rope, Q, K, V, U};
      pg8::gemm_phase<EpiInG, pg8::StaticOrder, PG8_ALIGN, PG8_SP2>(ldsl, g, S, e); }
    grid.sync();
    { const int G = (int)gridDim.x, bx = (int)blockIdx.x; const int vcu = (G % 8 == 0) ? (bx % 8) * (G / 8) + bx / 8 : bx;
      attn_body::attn_phase<8>((char*)lds_raw, (const attn_body::bf16*)Q, (const attn_body::bf16*)K, (const attn_body::bf16*)V, attn_out_norm, MIX, vcu, G); }
    pool_phase(lds, U, w_pool, pool_scale, MIX);
    grid.sync();
    { pg8::Gemm g{MIX, WOUT, MR, DM, DM}; pg8::StaticOrder S; S.init(MR, DM, (int)gridDim.x, (int)blockIdx.x); EpiOutG e{x, args.out, A2, SSQ2};
      pg8::gemm_phase<EpiOutG, pg8::StaticOrder, PG8_ALIGN, PG8_SP2>(ldsl, g, S, e); }
    grid.sync();
    { pg8::Gemm g{A2, WFI, MR, 2 * DFF, DM}; pg8::StaticOrder S; S.init(MR, 2 * DFF, (int)gridDim.x, (int)blockIdx.x); EpiFfnInG e{SSQ2, ACT};
      pg8::gemm_phase<EpiFfnInG, pg8::StaticOrder, PG8_ALIGN, PG8_SP2>(ldsl, g, S, e); }
    grid.sync();
    { pg8::Gemm g{ACT, WFD, MR, DM, DFF}; pg8::StaticOrder S; S.init(MR, DM, (int)gridDim.x, (int)blockIdx.x); EpiDownG e{args.out, SSQ3};
      pg8::gemm_phase<EpiDownG, pg8::StaticOrder, PG8_ALIGN, PG8_SP2>(ldsl, g, S, e); }
    grid.sync();
    final_norm(args.out, SSQ3, norm_final);
}

extern "C" void kernel_launch(void* const* d_in, const int* in_sizes, int n_in, void* d_out, int out_size, void* d_ws, size_t ws_size, hipStream_t stream) {
    static int grid = 0;
    if (grid == 0) {
        int dev = 0, cus = 0, per_cu = 0;
        hipGetDevice(&dev);
        hipDeviceGetAttribute(&cus, hipDeviceAttributeMultiprocessorCount, dev);
        hipFuncSetAttribute((const void*)fwd_kernel, hipFuncAttributeMaxDynamicSharedMemorySize, LDS_BYTES);
        hipOccupancyMaxActiveBlocksPerMultiprocessor(&per_cu, (const void*)fwd_kernel, NTHREADS, LDS_BYTES);
        if (per_cu < 1) { fprintf(stderr, "kernel_launch: occupancy query says %d blocks per CU\n", per_cu); per_cu = 1; }
        (void)hipGetLastError();
        grid = cus;
    }
    Args a{};
    for (int i = 0; i < 14; ++i) a.in[i] = (const float*)d_in[i];
    a.out = (float*)d_out; a.ws = (unsigned char*)d_ws;
    void* params[] = {&a};
    hipError_t e = hipLaunchCooperativeKernel((const void*)fwd_kernel, dim3(grid), dim3(NTHREADS), params, LDS_BYTES, stream);
    if (e != hipSuccess) fprintf(stderr, "cooperative launch failed: %s (grid %d)\n", hipGetErrorString(e), grid);
}
```

```cpp
#include <hip/hip_runtime.h>
#include <hip/hip_cooperative_groups.h>
#include <cstdio>
#include <cstdint>
namespace cg = cooperative_groups;

typedef unsigned short bf16_t;
typedef float f32x4 __attribute__((ext_vector_type(4)));
typedef unsigned u32x4 __attribute__((ext_vector_type(4)));

constexpr int NB = 8, SEQ = 4096, DM = 1024, NMETA = 16;
constexpr int MR = NB * SEQ;
constexpr int MP = 33024;
constexpr int DATT = 512, DKV = 128, DPOOL = 512, DIN = 1280, DFF = 2816;
constexpr int LKEYS = SEQ + NMETA;
constexpr float EPS = 1e-6f;
constexpr float C2 = 0.125f * 1.4426950408889634f;

constexpr size_t MiB = 1u << 20;
constexpr size_t WS_ROPE = 1 * MiB;
constexpr size_t WS_WIN = 2 * MiB, WS_WOUT = 5 * MiB, WS_WFI = 7 * MiB, WS_WFD = 18 * MiB, WS_WPOOL = 23 * MiB + 512 * 1024;
constexpr size_t WS_HN = 24 * MiB;
constexpr size_t WS_Q = 89 * MiB;
constexpr size_t WS_K = 122 * MiB;
constexpr size_t WS_V = 131 * MiB;
constexpr size_t WS_U = 140 * MiB;
constexpr size_t WS_MIX = 173 * MiB;
constexpr size_t WS_A2 = 237 * MiB;
constexpr size_t WS_SSQ2 = 301 * MiB;
constexpr size_t WS_SSQ3 = 303 * MiB;
constexpr size_t WS_ACT = 24 * MiB;

constexpr int NTHREADS = 512;
constexpr int LDS_BYTES = 147456;

struct Args { const float* in[14]; float* out; unsigned char* ws; };

__device__ __forceinline__ unsigned f2bf(float f) { unsigned u = __builtin_bit_cast(unsigned, f); return (u + 0x7fffu + ((u >> 16) & 1u)) >> 16; }
__device__ __forceinline__ float bf2f(unsigned h) { return __builtin_bit_cast(float, h << 16); }
__device__ __forceinline__ unsigned pk2(float lo, float hi) { return f2bf(lo) | (f2bf(hi) << 16); }
__device__ __forceinline__ float wave_sum(float v) {
#pragma unroll
    for (int o = 1; o < 64; o <<= 1) v += __shfl_xor(v, o);
    return v;
}
__device__ __forceinline__ float wave_max(float v) {
#pragma unroll
    for (int o = 1; o < 64; o <<= 1) v = fmaxf(v, __shfl_xor(v, o));
    return v;
}

namespace pg8 {
#define PG8_LAS __attribute__((address_space(3)))
typedef unsigned short bf16_t;
typedef short bf16x8 __attribute__((ext_vector_type(8)));
typedef float f32x4 __attribute__((ext_vector_type(4)));
typedef unsigned u32x4 __attribute__((ext_vector_type(4)));
constexpr int BM = 256, BK = 64, HALF = 128, HTB = HALF * BK * 2  , STAGE_BYTES = 8 * HTB, NXCD = 8, WGM = 8;

__host__ __device__ __forceinline__ int lds_byte(int r, int c) { const int st = (r >> 4) * 2 + (c >> 5), rr = r & 15, cc = c & 31, ob = rr * 64 + cc * 2; return st * 1024 + (ob ^ (((ob >> 9) & 1) << 5)); }
__host__ __device__ __forceinline__ void stage_rc(int b, int& R, int& C) { const int st = b / 1024, sb = b % 1024, swz = sb ^ (((sb >> 9) & 1) << 5); R = (st >> 1) * 16 + swz / 64; C = (st & 1) * 32 + (swz % 64) / 2; }
__host__ __device__ __forceinline__ int perm32(int rho) { const int n = rho >> 4, i = rho & 15; return 8 * (i >> 2) + 4 * n + (i & 3); }

struct Unit { int pm, pn; };
struct Gemm { const bf16_t* A; const bf16_t* Bt; int M, N, K; };

struct StaticOrder {
    int nM, nN, nwg, G, c;
    __host__ __device__ void init(int M, int N, int G_, int c_) { nM = M / BM; nN = N / BM; nwg = nM * nN; G = G_; c = c_; }
    __host__ __device__ bool next(int i, Unit& u) const {
        const long L = (long)i * G + c; if (L >= nwg) return false;
        int wgid = (int)L; { const int q = nwg / NXCD, r = nwg % NXCD, xcd = wgid % NXCD, off = wgid / NXCD; wgid = (xcd < r ? xcd * (q + 1) : r * (q + 1) + (xcd - r) * q) + off; }
        const int nig = WGM * nN, gid = wgid / nig, fm = gid * WGM, gsz = (nM - fm) < WGM ? (nM - fm) : WGM;
        u.pm = fm + ((wgid % nig) % gsz); u.pn = (wgid % nig) / gsz; return true;
    }
    __device__ __forceinline__ void a_ready(const Unit&) const {}
    __device__ __forceinline__ void done(const Unit&) const {}
};

__device__ __forceinline__ unsigned cvt_pk_bf16(float lo, float hi) { unsigned r; asm volatile("v_cvt_pk_bf16_f32 %0, %1, %2" : "=v"(r) : "v"(lo), "v"(hi)); return r; }
typedef float f32x2 __attribute__((ext_vector_type(2)));
template <class Epi, class Sched, bool ALIGN_EPI = false, bool SP2 = false>
__device__ __forceinline__ void gemm_phase(PG8_LAS unsigned char* lds, const Gemm g, const Sched& S, const Epi& E) {
    int tid_ = threadIdx.x; asm volatile("" : "+v"(tid_));
    const int tid = tid_, wid = __builtin_amdgcn_readfirstlane(tid >> 6), lane = tid & 63, wr = wid >> 2, wc = wid & 3, fr = lane & 15, fq = lane >> 4;
    const int K = g.K, nt = K / BK;
    unsigned voffA[2], voffB[2];
#pragma unroll
    for (int i = 0; i < 2; ++i) { int R, C; stage_rc(tid * 16 + i * 8192, R, C); const int Rb = Epi::PERM ? ((R & ~31) + perm32(R & 31)) : R;
        voffA[i] = (unsigned)(R * K + C) * 2u; voffB[i] = (unsigned)(Rb * K + C) * 2u; }
    const size_t kstep = (size_t)(BK * 2);
    const size_t hstep = (size_t)HALF * K * 2;
    const size_t tstep = 2 * hstep;
    const unsigned ldsw = (unsigned)wid * 1024u;
    const int aoff = lds_byte(wr * 64 + fr, fq * 8), boff = lds_byte(wc * 32 + fr, fq * 8);
#define PG8_SA(b, h) (((b) * 2 + (h)) * HTB)
#define PG8_SB(b, h) ((4 + (b) * 2 + (h)) * HTB)
#define PG8_STAGE(bufoff, gbase, voff) do { _Pragma("unroll") for (int _i = 0; _i < 2; ++_i) \
        __builtin_amdgcn_global_load_lds((const unsigned*)((const char*)(gbase) + (voff)[_i]), (PG8_LAS unsigned*)(lds + (bufoff) + ldsw + _i * 8192), 16, 0, 0); } while (0)
#define PG8_LDA(dst, b, h) do { _Pragma("unroll") for (int m = 0; m < 4; ++m) _Pragma("unroll") for (int k = 0; k < 2; ++k) dst[m][k] = *(const PG8_LAS bf16x8*)(lds + PG8_SA(b, h) + aoff + m * 2048 + k * 1024); } while (0)
#define PG8_LDB(dst, b, h) do { _Pragma("unroll") for (int n = 0; n < 2; ++n) _Pragma("unroll") for (int k = 0; k < 2; ++k) dst[n][k] = *(const PG8_LAS bf16x8*)(lds + PG8_SB(b, h) + boff + n * 2048 + k * 1024); } while (0)
#define PG8_MMA(ai, bj, At, Bt) do { __builtin_amdgcn_s_setprio(1); _Pragma("unroll") for (int m = 0; m < 4; ++m) _Pragma("unroll") for (int n = 0; n < 2; ++n) _Pragma("unroll") for (int k = 0; k < 2; ++k) \
        acc[ai][bj][m][n] = __builtin_amdgcn_mfma_f32_16x16x32_bf16(Bt[n][k], At[m][k], acc[ai][bj][m][n], 0, 0, 0); __builtin_amdgcn_s_setprio(0); } while (0)
#define PG8_WAIT_V(n) asm volatile("s_waitcnt vmcnt(" #n ")" ::: "memory")
#define PG8_WAIT_L(n) asm volatile("s_waitcnt lgkmcnt(" #n ")" ::: "memory")
#define PG8_BAR __builtin_amdgcn_s_barrier()
#define PG8_SCHED __builtin_amdgcn_sched_barrier(0)
    Unit cur, nxt; int ui = 0;
    if (!S.next(0, cur)) return;
    f32x4 acc[2][2][4][2];
#pragma unroll
    for (int a = 0; a < 2; ++a)
#pragma unroll
        for (int b = 0; b < 2; ++b)
#pragma unroll
            for (int m = 0; m < 4; ++m)
#pragma unroll
                for (int n = 0; n < 2; ++n) acc[a][b][m][n] = (f32x4){0.f, 0.f, 0.f, 0.f};
    bf16x8 At[4][2], B0[2][2], B1[2][2];
    const char* cA = (const char*)g.A + (size_t)cur.pm * tstep; const char* cB = (const char*)g.Bt + (size_t)cur.pn * tstep;
    S.a_ready(cur);
    if constexpr (SP2) {
        PG8_STAGE(PG8_SB(0, 0), cB, voffB); PG8_STAGE(PG8_SB(0, 1), cB + hstep, voffB); PG8_STAGE(PG8_SA(0, 0), cA, voffA); PG8_STAGE(PG8_SA(0, 1), cA + hstep, voffA);
        if (wr == 1) PG8_BAR;
        PG8_WAIT_V(2); PG8_BAR;
        PG8_STAGE(PG8_SB(1, 0), cB + kstep, voffB); PG8_STAGE(PG8_SA(1, 0), cA + kstep, voffA); PG8_STAGE(PG8_SB(1, 1), cB + hstep + kstep, voffB);
        PG8_WAIT_V(6); PG8_BAR;
    } else {
        PG8_STAGE(PG8_SB(0, 0), cB, voffB); PG8_STAGE(PG8_SA(0, 0), cA, voffA); PG8_STAGE(PG8_SB(0, 1), cB + hstep, voffB); PG8_STAGE(PG8_SA(0, 1), cA + hstep, voffA);
        if (wr == 1) PG8_BAR;
        PG8_WAIT_V(4); PG8_BAR;
        PG8_STAGE(PG8_SB(1, 0), cB + kstep, voffB); PG8_STAGE(PG8_SA(1, 0), cA + kstep, voffA); PG8_STAGE(PG8_SB(1, 1), cB + hstep + kstep, voffB);
        PG8_WAIT_V(6); PG8_BAR;
    }
    for (;;) {
        const bool has_next = S.next(ui + 1, nxt);
        const char* nA = has_next ? (const char*)g.A + (size_t)nxt.pm * tstep : cA; const char* nB = has_next ? (const char*)g.Bt + (size_t)nxt.pn * tstep : cB;
        for (int t = 0; t < nt; t += 2) {
            const bool last = (t == nt - 2);
            const char* a1 = cA + (size_t)(t + 1) * kstep;
            const char* a2 = last ? nA : cA + (size_t)(t + 2) * kstep; const char* b2 = last ? nB : cB + (size_t)(t + 2) * kstep;
            const char* a3 = a2 + kstep; const char* b3 = b2 + kstep;
            if (last && has_next) S.a_ready(nxt);
            if constexpr (SP2) {
            PG8_LDB(B0, 0, 0); PG8_LDB(B1, 0, 1); PG8_SCHED; PG8_LDA(At, 0, 0); PG8_STAGE(PG8_SA(1, 1), a1 + hstep, voffA);
            PG8_WAIT_V(8); PG8_WAIT_L(0); PG8_BAR; PG8_MMA(0, 0, At, B0); PG8_MMA(0, 1, At, B1); PG8_BAR; PG8_SCHED;
            PG8_LDA(At, 0, 1); PG8_STAGE(PG8_SB(0, 0), b2, voffB); PG8_STAGE(PG8_SB(0, 1), b2 + hstep, voffB); PG8_STAGE(PG8_SA(0, 0), a2, voffA);
            PG8_WAIT_V(8); PG8_WAIT_L(0); PG8_BAR; PG8_MMA(1, 0, At, B0); PG8_MMA(1, 1, At, B1); PG8_BAR; PG8_SCHED;
            PG8_LDB(B0, 1, 0); PG8_LDB(B1, 1, 1); PG8_SCHED; PG8_LDA(At, 1, 0); PG8_STAGE(PG8_SA(0, 1), a2 + hstep, voffA);
            PG8_WAIT_V(8); PG8_WAIT_L(0); PG8_BAR; PG8_MMA(0, 0, At, B0); PG8_MMA(0, 1, At, B1); PG8_BAR; PG8_SCHED;
            PG8_LDA(At, 1, 1); PG8_STAGE(PG8_SB(1, 0), b3, voffB); PG8_STAGE(PG8_SB(1, 1), b3 + hstep, voffB); PG8_STAGE(PG8_SA(1, 0), a3, voffA);
            PG8_WAIT_V(8); PG8_WAIT_L(0); PG8_BAR; PG8_MMA(1, 0, At, B0); PG8_MMA(1, 1, At, B1); PG8_BAR; PG8_SCHED;
            } else {
            PG8_LDB(B0, 0, 0); PG8_SCHED; PG8_LDA(At, 0, 0); PG8_STAGE(PG8_SA(1, 1), a1 + hstep, voffA);
            PG8_WAIT_L(8); PG8_BAR; PG8_WAIT_L(0); PG8_MMA(0, 0, At, B0); PG8_BAR; PG8_SCHED;
            PG8_LDB(B1, 0, 1); PG8_STAGE(PG8_SB(0, 0), b2, voffB);
            PG8_BAR; PG8_WAIT_L(0); PG8_MMA(0, 1, At, B1); PG8_BAR;
            PG8_LDA(At, 0, 1); PG8_STAGE(PG8_SA(0, 0), a2, voffA);
            PG8_BAR; PG8_WAIT_L(0); PG8_MMA(1, 0, At, B0); PG8_BAR; PG8_SCHED;
            PG8_STAGE(PG8_SB(0, 1), b2 + hstep, voffB);
            PG8_WAIT_V(6); PG8_BAR; PG8_MMA(1, 1, At, B1); PG8_BAR;
            PG8_LDB(B0, 1, 0); PG8_SCHED; PG8_LDA(At, 1, 0); PG8_STAGE(PG8_SA(0, 1), a2 + hstep, voffA);
            PG8_WAIT_L(8); PG8_BAR; PG8_WAIT_L(0); PG8_MMA(0, 0, At, B0); PG8_BAR; PG8_SCHED;
            PG8_LDB(B1, 1, 1); PG8_STAGE(PG8_SB(1, 0), b3, voffB);
            PG8_BAR; PG8_WAIT_L(0); PG8_MMA(0, 1, At, B1); PG8_BAR;
            PG8_LDA(At, 1, 1); PG8_STAGE(PG8_SA(1, 0), a3, voffA);
            PG8_BAR; PG8_WAIT_L(0); PG8_MMA(1, 0, At, B0); PG8_BAR; PG8_SCHED;
            PG8_STAGE(PG8_SB(1, 1), b3 + hstep, voffB);
            PG8_WAIT_V(6); PG8_BAR; PG8_MMA(1, 1, At, B1); PG8_BAR;
            }
        }
        if constexpr (ALIGN_EPI) { if (wr == 0) PG8_BAR; }
        if constexpr (!Epi::AFTER_DRAIN) { E(acc, cur, wr, wc, fr, fq); S.done(cur); }
        if (!has_next) break;
#pragma unroll
        for (int a = 0; a < 2; ++a)
#pragma unroll
            for (int b = 0; b < 2; ++b)
#pragma unroll
                for (int m = 0; m < 4; ++m)
#pragma unroll
                    for (int n = 0; n < 2; ++n) acc[a][b][m][n] = (f32x4){0.f, 0.f, 0.f, 0.f};
        cur = nxt; cA = nA; cB = nB; ++ui;
        if constexpr (ALIGN_EPI) { if (wr == 1) PG8_BAR; }
    }
    PG8_WAIT_V(0);
    if constexpr (!ALIGN_EPI) { if (wr == 0) PG8_BAR; }
    PG8_BAR;
    if constexpr (Epi::AFTER_DRAIN) { E.fused(acc, cur, wr, wc, fr, fq, lds, wid, lane); S.done(cur); }
#undef PG8_SA
#undef PG8_SB
#undef PG8_STAGE
#undef PG8_LDA
#undef PG8_LDB
#undef PG8_MMA
#undef PG8_WAIT_V
#undef PG8_WAIT_L
#undef PG8_BAR
#undef PG8_SCHED
}
}

#ifndef PG8_SP2
#define PG8_SP2 true
#endif
#ifndef PG8_ALIGN
#define PG8_ALIGN true
#endif
#define LAS __attribute__((address_space(3)))

__device__ __forceinline__ void transpose_item(const float* W, int K, int N, const float* kg, bf16_t* WT, int k0, int n_src0, int p0, LAS float* scr, int lane) {
#pragma unroll 8
    for (int i = 0; i < 32; ++i) { const int kk = 2 * i + (lane >> 5); float w = W[(size_t)(k0 + kk) * N + n_src0 + (lane & 31)]; if (kg) w *= kg[k0 + kk]; scr[kk * 33 + (lane & 31)] = w; }
    asm volatile("s_waitcnt lgkmcnt(0)" ::: "memory");
    const int c = lane & 7;
#pragma unroll
    for (int j = 0; j < 4; ++j) { const int n = (lane >> 3) + 8 * j; const LAS float* s = scr + (8 * c) * 33 + n;
        u32x4 o; o.x = pk2(s[0 * 33], s[1 * 33]); o.y = pk2(s[2 * 33], s[3 * 33]); o.z = pk2(s[4 * 33], s[5 * 33]); o.w = pk2(s[6 * 33], s[7 * 33]);
        *(u32x4*)(WT + (size_t)(p0 + n) * K + k0 + 8 * c) = o; }
    asm volatile("s_waitcnt lgkmcnt(0)" ::: "memory");
}
__device__ __forceinline__ void convert_weights(LAS unsigned char* lds, const float* w_in, const float* w_out, const float* w_ffn_in, const float* norm_ffn, const float* w_down,
                                                bf16_t* WIN, bf16_t* WOUT, bf16_t* WFI, bf16_t* WFD, const float* w_pool, bf16_t* WPT) {
    int tid_ = threadIdx.x; asm volatile("" : "+v"(tid_));
    const int lane = tid_ & 63, wave = tid_ >> 6;
    LAS float* scr = (LAS float*)(lds + wave * 16384);
    const int gw = blockIdx.x * 8 + wave, NGW = gridDim.x * 8;
    constexpr int I_IN = 16 * 40, I_OUT = 16 * 32, I_FI = 16 * 176, I_FD = 44 * 32, I_PL = 32;
    for (int it = gw; it < I_PL + I_IN + I_OUT + I_FI + I_FD; it += NGW) {
        int r = it;
        if (r < I_PL) { const int g = r >> 3, kb = (r >> 2) & 1, grp = r & 3; transpose_item(w_pool + (size_t)g * 16384, 128, 128, nullptr, WPT + (size_t)g * 16384, kb * 64, 32 * grp, 32 * grp, scr, lane); continue; }
        r -= I_PL;
        if (r < I_IN) { const int kb = r / 40, grp = r % 40, pn = grp >> 3, rem = grp & 7, bj = rem >> 2, wc = rem & 3;
            transpose_item(w_in, DM, DIN, nullptr, WIN, kb * 64, 256 * pn + 64 * wc + 32 * bj, 32 * grp, scr, lane); continue; }
        r -= I_IN;
        if (r < I_OUT) { const int kb = r / 32, grp = r % 32; transpose_item(w_out, DM, DM, nullptr, WOUT, kb * 64, 32 * grp, 32 * grp, scr, lane); continue; }
        r -= I_OUT;
        if (r < I_FI) { const int kb = r / 176, grp = r % 176, pn = grp >> 3, rem = grp & 7, bj = rem >> 2, q = rem & 3;
            transpose_item(w_ffn_in, DM, 2 * DFF, norm_ffn, WFI, kb * 64, 128 * pn + 32 * q + bj * DFF, 32 * grp, scr, lane); continue; }
        r -= I_FI;
        { const int kb = r / 32, grp = r % 32; transpose_item(w_down, DFF, DM, nullptr, WFD, kb * 64, 32 * grp, 32 * grp, scr, lane); }
    }
}

struct EpiDownG {
    static constexpr bool PERM = true, AFTER_DRAIN = false;
    float* out; float* ssq;
    __device__ __forceinline__ void operator()(const pg8::f32x4 (&acc)[2][2][4][2], const pg8::Unit& u, int wr, int wc, int fr, int fq) const {
        const int row0 = u.pm * 256 + wr * 64 + fr, col0 = u.pn * 256 + wc * 32 + 8 * fq;
#pragma unroll
        for (int ai = 0; ai < 2; ++ai)
#pragma unroll
            for (int m = 0; m < 4; ++m) {
                const int row = row0 + ai * 128 + m * 16;
                float* rp = out + (size_t)row * DM + col0; float s = 0.f;
#pragma unroll
                for (int bj = 0; bj < 2; ++bj) {
                    f32x4 a = *(const f32x4*)(rp + bj * 128), b = *(const f32x4*)(rp + bj * 128 + 4);
                    a += acc[ai][bj][m][0]; b += acc[ai][bj][m][1];
                    *(f32x4*)(rp + bj * 128) = a; *(f32x4*)(rp + bj * 128 + 4) = b;
                    s += (a.x * a.x + a.y * a.y) + (a.z * a.z + a.w * a.w) + (b.x * b.x + b.y * b.y) + (b.z * b.z + b.w * b.w);
                }
                s += __shfl_xor(s, 16); s += __shfl_xor(s, 32);
                if (fq == 0) ssq[(size_t)row * 16 + u.pn * 4 + wc] = s;
            }
    }
};


typedef unsigned u32x2 __attribute__((ext_vector_type(2)));
struct EpiOutG {
    static constexpr bool PERM = true, AFTER_DRAIN = false;
    const float* x; float* out; bf16_t* A2; float* ssq;
    __device__ __forceinline__ void operator()(const pg8::f32x4 (&acc)[2][2][4][2], const pg8::Unit& u, int wr, int wc, int fr, int fq) const {
        const int row0 = u.pm * 256 + wr * 64 + fr, col0 = u.pn * 256 + wc * 32 + 8 * fq;
#pragma unroll
        for (int ai = 0; ai < 2; ++ai)
#pragma unroll
            for (int m = 0; m < 4; ++m) {
                const int row = row0 + ai * 128 + m * 16;
                const size_t off = (size_t)row * DM + col0; float s = 0.f;
#pragma unroll
                for (int bj = 0; bj < 2; ++bj) {
                    f32x4 a = *(const f32x4*)(x + off + bj * 128), b = *(const f32x4*)(x + off + bj * 128 + 4);
                    a += acc[ai][bj][m][0]; b += acc[ai][bj][m][1];
                    *(f32x4*)(out + off + bj * 128) = a; *(f32x4*)(out + off + bj * 128 + 4) = b;
                    u32x4 w; w.x = pg8::cvt_pk_bf16(a.x, a.y); w.y = pg8::cvt_pk_bf16(a.z, a.w); w.z = pg8::cvt_pk_bf16(b.x, b.y); w.w = pg8::cvt_pk_bf16(b.z, b.w);
                    *(u32x4*)(A2 + off + bj * 128) = w;
                    s += (a.x * a.x + a.y * a.y) + (a.z * a.z + a.w * a.w) + (b.x * b.x + b.y * b.y) + (b.z * b.z + b.w * b.w);
                }
                s += __shfl_xor(s, 16); s += __shfl_xor(s, 32);
                if (fq == 0) ssq[(size_t)row * 16 + u.pn * 4 + wc] = s;
            }
    }
};
__device__ __forceinline__ float silu_mul(float g, float u) { return g * __builtin_amdgcn_rcpf(1.f + __builtin_amdgcn_exp2f(-1.4426950408889634f * g)) * u; }
struct EpiFfnInG {
    static constexpr bool PERM = true, AFTER_DRAIN = false;
    const float* ssq; bf16_t* ACT;
    __device__ __forceinline__ void operator()(const pg8::f32x4 (&acc)[2][2][4][2], const pg8::Unit& u, int wr, int wc, int fr, int fq) const {
        const int row0 = u.pm * 256 + wr * 64 + fr, col0 = u.pn * 128 + wc * 32 + 8 * fq;
#pragma unroll
        for (int ai = 0; ai < 2; ++ai)
#pragma unroll
            for (int m = 0; m < 4; ++m) {
                const int row = row0 + ai * 128 + m * 16;
                const f32x4* sp = (const f32x4*)(ssq + (size_t)row * 16);
                const f32x4 s0 = sp[0], s1 = sp[1], s2 = sp[2], s3 = sp[3];
                const float t = ((s0.x + s0.y) + (s0.z + s0.w)) + ((s1.x + s1.y) + (s1.z + s1.w)) + ((s2.x + s2.y) + (s2.z + s2.w)) + ((s3.x + s3.y) + (s3.z + s3.w));
                const float rs = 1.0f / sqrtf(t * (1.f / DM) + EPS);
                const f32x4 g0 = acc[ai][0][m][0] * rs, g1 = acc[ai][0][m][1] * rs, u0 = acc[ai][1][m][0] * rs, u1 = acc[ai][1][m][1] * rs;
                u32x4 w;
                w.x = pg8::cvt_pk_bf16(silu_mul(g0.x, u0.x), silu_mul(g0.y, u0.y)); w.y = pg8::cvt_pk_bf16(silu_mul(g0.z, u0.z), silu_mul(g0.w, u0.w));
                w.z = pg8::cvt_pk_bf16(silu_mul(g1.x, u1.x), silu_mul(g1.y, u1.y)); w.w = pg8::cvt_pk_bf16(silu_mul(g1.z, u1.z), silu_mul(g1.w, u1.w));
                *(u32x4*)(ACT + (size_t)row * DFF + col0) = w;
            }
    }
};
struct EpiInG {
    static constexpr bool PERM = false, AFTER_DRAIN = false;
    const float* qn; const float* kn; const float* rope; bf16_t* Q; bf16_t* K; bf16_t* V; bf16_t* U;
    __device__ __forceinline__ void operator()(const pg8::f32x4 (&acc)[2][2][4][2], const pg8::Unit& u, int wr, int wc, int fr, int fq) const {
        const int g = 4 * u.pn + wc;
        const int row0 = u.pm * 256 + wr * 64 + fr;
        if (g < 10) {
            const float* gn = g < 8 ? qn : kn;
            f32x4 gv[2][2];
#pragma unroll
            for (int bj = 0; bj < 2; ++bj)
#pragma unroll
                for (int n = 0; n < 2; ++n) gv[bj][n] = *(const f32x4*)(gn + 32 * bj + 16 * n + 4 * fq);
            const float osc = g < 8 ? C2 : 1.f;
            bf16_t* base = g < 8 ? Q + g * 64 : K + (g - 8) * 64; const int pitch = g < 8 ? DATT : DKV;
#pragma unroll
            for (int ai = 0; ai < 2; ++ai)
#pragma unroll
                for (int m = 0; m < 4; ++m) {
                    const int row = row0 + ai * 128 + m * 16;
                    float s = 0.f;
#pragma unroll
                    for (int bj = 0; bj < 2; ++bj)
#pragma unroll
                        for (int n = 0; n < 2; ++n) { const f32x4 v = acc[ai][bj][m][n]; s += (v.x * v.x + v.y * v.y) + (v.z * v.z + v.w * v.w); }
                    s += __shfl_xor(s, 16); s += __shfl_xor(s, 32);
                    const float rn = (1.0f / sqrtf(s * (1.f / 64.f) + EPS));
                    const int sidx = row & (SEQ - 1);
#pragma unroll
                    for (int bj = 0; bj < 2; ++bj) {
                        f32x4 cc = (f32x4){1.f, 1.f, 1.f, 1.f}, ss = (f32x4){0.f, 0.f, 0.f, 0.f};
                        if (row < MR) {
                            const int ci = bj == 0 ? (sidx >> 6) : (sidx & 63);
                            const f32x4* tp = (const f32x4*)(rope + (ci * 16 + 4 * fq) * 2);
                            const f32x4 t0 = tp[0], t1 = tp[1];
                            cc = (f32x4){t0.x, t0.z, t1.x, t1.z}; ss = (f32x4){t0.y, t0.w, t1.y, t1.w};
                        }
                        const f32x4 x0 = acc[ai][bj][m][0] * rn * gv[bj][0], x1 = acc[ai][bj][m][1] * rn * gv[bj][1];
                        const f32x4 o0 = (x0 * cc - x1 * ss) * osc, o1 = (x0 * ss + x1 * cc) * osc;
                        bf16_t* p = base + (size_t)row * pitch + 32 * bj + 4 * fq;
                        u32x2 w0, w1; w0.x = pg8::cvt_pk_bf16(o0.x, o0.y); w0.y = pg8::cvt_pk_bf16(o0.z, o0.w); w1.x = pg8::cvt_pk_bf16(o1.x, o1.y); w1.y = pg8::cvt_pk_bf16(o1.z, o1.w);
                        *(u32x2*)p = w0; *(u32x2*)(p + 16) = w1;
                    }
                }
        } else {
            bf16_t* base = g < 12 ? V + (g - 10) * 64 : U + (g - 12) * 64; const int pitch = g < 12 ? DKV : DPOOL;
#pragma unroll
            for (int ai = 0; ai < 2; ++ai)
#pragma unroll
                for (int m = 0; m < 4; ++m) {
                    const int row = row0 + ai * 128 + m * 16;
#pragma unroll
                    for (int bj = 0; bj < 2; ++bj)
#pragma unroll
                        for (int n = 0; n < 2; ++n) { const f32x4 v = acc[ai][bj][m][n]; u32x2 w; w.x = pg8::cvt_pk_bf16(v.x, v.y); w.y = pg8::cvt_pk_bf16(v.z, v.w);
                            *(u32x2*)(base + (size_t)row * pitch + 32 * bj + 16 * n + 4 * fq) = w; }
                }
        }
    }
};

__device__ __forceinline__ void rope_table(float* tab) {
    for (int idx = blockIdx.x * NTHREADS + threadIdx.x; idx < 64 * 16; idx += gridDim.x * NTHREADS) {
        const int ci = idx >> 4, i = idx & 15;
        const int lo = i & 3, hi = i >> 2;
        double f = lo == 0 ? 1.0 : lo == 1 ? 0.5623413251903491 : lo == 2 ? 0.31622776601683794 : 0.1778279410038923;
        f *= hi == 0 ? 1.0 : hi == 1 ? 0.1 : hi == 2 ? 0.01 : 0.001;
        const float ang_f = (float)(ci - 32) * (float)f;
        double a = (double)ang_f;
        a -= 6.283185307179586 * __builtin_rint(a * 0.15915494309189535);
        const double a2 = a * a;
        double sn = a, cs = 1.0, ts = a, tc = 1.0;
        for (int k = 1; k <= 16; ++k) {
            tc *= -a2 / (double)((2 * k - 1) * (2 * k));
            ts *= -a2 / (double)((2 * k) * (2 * k + 1));
            cs += tc; sn += ts;
        }
        tab[2 * idx] = (float)cs; tab[2 * idx + 1] = (float)sn;
    }
}
__device__ __forceinline__ void rms_rows_p0(const float* x, const float* meta, const float* g, bf16_t* HN) {
    int tid_ = threadIdx.x; asm volatile("" : "+v"(tid_));
    const int lane = tid_ & 63, gw = blockIdx.x * 8 + (tid_ >> 6), NGW = gridDim.x * 8;
    f32x4 gv[4];
#pragma unroll
    for (int j = 0; j < 4; ++j) gv[j] = *((const f32x4*)g + lane + 64 * j);
    for (int m = gw; m < MP; m += NGW) {
        unsigned long long* o8 = (unsigned long long*)(HN + (size_t)m * DM) + lane;
        if (m >= MR + NMETA) {
#pragma unroll
            for (int j = 0; j < 4; ++j) o8[64 * j] = 0ull;
            continue;
        }
        const float* src = m < MR ? x + (size_t)m * DM : meta + (size_t)(m - MR) * DM;
        const f32x4* xr = (const f32x4*)src + lane;
        f32x4 v[4]; float s = 0.f;
#pragma unroll
        for (int j = 0; j < 4; ++j) { v[j] = xr[64 * j]; s += (v[j].x * v[j].x + v[j].y * v[j].y) + (v[j].z * v[j].z + v[j].w * v[j].w); }
        const float rs = 1.0f / sqrtf(wave_sum(s) * (1.f / DM) + EPS);
#pragma unroll
        for (int j = 0; j < 4; ++j) {
            const f32x4 y = v[j] * rs * gv[j];
            o8[64 * j] = (unsigned long long)pk2(y.x, y.y) | ((unsigned long long)pk2(y.z, y.w) << 32);
        }
    }
}

#include <hip/hip_bf16.h>
#include <cmath>
namespace attn_body {
using bf16=__hip_bfloat16;
using bf16x8=__attribute__((ext_vector_type(8)))short;
using s16x4=__attribute__((ext_vector_type(4)))short;
using f32x16=__attribute__((ext_vector_type(16)))float;
using u32x4=__attribute__((ext_vector_type(4)))unsigned;
using f32x4v=__attribute__((ext_vector_type(4)))float;
constexpr int D=64,QP=512,KP=128;
constexpr int NW=8,QBLK=32,KVBLK=64,NT=65,NREAL=64;
__device__ __forceinline__ int crow(int r,int hi){return (r&3)+8*(r>>2)+4*hi;}
#define SBAR() __builtin_amdgcn_sched_barrier(0)
__device__ __forceinline__ void mmask(f32x16&p0,f32x16&p1){
  const float NEG=-INFINITY;
  #pragma unroll
  for(int r=8;r<16;++r)p0[r]=NEG;
  #pragma unroll
  for(int r=0;r<16;++r)p1[r]=NEG;
}

constexpr int NSLOT=3, SLOTB=8192;
constexpr int OB_PITCH=1040;
constexpr int LDS_K=0, LDS_V=NSLOT*SLOTB, LDS_WS=2*NSLOT*SLOTB, LDS_OB=LDS_WS+NW*64*4, LDS_BYTES=LDS_OB+64*OB_PITCH;
constexpr float C2=0.125f*1.4426950408889634f;
__device__ __forceinline__ void glds16(const void*gsrc,unsigned lds_dst){unsigned keep;
  asm volatile("s_mov_b32 %0, m0\n\ts_mov_b32 m0, %2\n\ts_nop 0\n\tglobal_load_lds_dwordx4 %1, off\n\ts_mov_b32 m0, %0":"=&s"(keep):"v"(gsrc),"s"(lds_dst):"memory");}
__device__ __forceinline__ float max3f(float a,float b,float c){float r;asm("v_max3_f32 %0, %1, %2, %3":"=v"(r):"v"(a),"v"(b),"v"(c));return r;}
__device__ __forceinline__ float max2f(float a,float b){float r;asm("v_max_f32_e32 %0, %1, %2":"=v"(r):"v"(a),"v"(b));return r;}
__device__ __forceinline__ float fadd_s(float a,float b){float r;asm("v_add_f32_e32 %0, %1, %2":"=v"(r):"v"(a),"v"(b));return r;}
__device__ __forceinline__ float fsub_s(float a,float b){float r;asm("v_sub_f32_e32 %0, %1, %2":"=v"(r):"v"(a),"v"(b));return r;}
typedef float f32x2_t __attribute__((ext_vector_type(2))); typedef __bf16 bf16x2_t __attribute__((ext_vector_type(2)));
__device__ __forceinline__ unsigned cvtpk_s(float lo,float hi){f32x2_t v={lo,hi};bf16x2_t b=__builtin_convertvector(v,bf16x2_t);return __builtin_bit_cast(unsigned,b);}
#define WAIT_BAR(N) asm volatile("s_waitcnt vmcnt(" #N ") lgkmcnt(0)\n\ts_barrier":::"memory")

__device__ __forceinline__ void qkt(f32x16&p0,f32x16&p1,const char*Kslot,const bf16x8*qr,const f32x16&negm,int r32,int hi){
  const char*kb=Kslot+hi*1024+r32*16;
  #pragma unroll
  for(int d0=0;d0<4;++d0){
    const bf16x8 b0=*reinterpret_cast<const bf16x8*>(kb+d0*2048);
    const bf16x8 b1=*reinterpret_cast<const bf16x8*>(kb+d0*2048+512);
    if(d0==0){p0=__builtin_amdgcn_mfma_f32_32x32x16_bf16(b0,qr[0],negm,0,0,0);p1=__builtin_amdgcn_mfma_f32_32x32x16_bf16(b1,qr[0],negm,0,0,0);}
    else{p0=__builtin_amdgcn_mfma_f32_32x32x16_bf16(b0,qr[d0],p0,0,0,0);p1=__builtin_amdgcn_mfma_f32_32x32x16_bf16(b1,qr[d0],p1,0,0,0);}}
}
typedef __attribute__((address_space(3))) const char* lds_cptr;
typedef short v4i16_t __attribute__((ext_vector_type(4)));
__device__ __forceinline__ void kload8(bf16x8*kf,lds_cptr kp){
  kf[0]=*(const __attribute__((address_space(3))) bf16x8*)(kp);      kf[1]=*(const __attribute__((address_space(3))) bf16x8*)(kp+512);
  kf[2]=*(const __attribute__((address_space(3))) bf16x8*)(kp+2048); kf[3]=*(const __attribute__((address_space(3))) bf16x8*)(kp+2560);
  kf[4]=*(const __attribute__((address_space(3))) bf16x8*)(kp+4096); kf[5]=*(const __attribute__((address_space(3))) bf16x8*)(kp+4608);
  kf[6]=*(const __attribute__((address_space(3))) bf16x8*)(kp+6144); kf[7]=*(const __attribute__((address_space(3))) bf16x8*)(kp+6656);
}
__device__ __forceinline__ void kload2(bf16x8*kf,lds_cptr kp,int j){ kf[2*j]=*(const __attribute__((address_space(3))) bf16x8*)(kp+j*2048); kf[2*j+1]=*(const __attribute__((address_space(3))) bf16x8*)(kp+j*2048+512); }
__device__ __forceinline__ s16x4 vtr(lds_cptr p){ return __builtin_bit_cast(s16x4,__builtin_amdgcn_ds_read_tr16_b64_v4i16((__attribute__((address_space(3))) v4i16_t*)p)); }
__device__ __forceinline__ float rowmax(const f32x16&p0,const f32x16&p1){
  float a=max3f(p0[0],p0[1],p1[0]),b=max3f(p0[2],p0[3],p1[1]);a=max3f(a,p1[2],p1[3]);
  #pragma unroll
  for(int r=4;r<16;r+=4){a=max3f(a,p0[r],p0[r+1]);b=max3f(b,p0[r+2],p0[r+3]);a=max3f(a,p1[r],p1[r+1]);b=max3f(b,p1[r+2],p1[r+3]);}
  const float m=max2f(a,b);
  auto rr=__builtin_amdgcn_permlane32_swap(__float_as_uint(m),__float_as_uint(m),false,false);
  return max2f(__uint_as_float(rr[0]),__uint_as_float(rr[1]));
}
__device__ __forceinline__ void pv(f32x16*o,int vb,bf16x8 pa0,bf16x8 pa1,bf16x8 pa2,bf16x8 pa3){
  #pragma unroll
  for(int d0=0;d0<2;++d0){s16x4 lo[4],hi[4];
    #pragma unroll
    for(int ks=0;ks<4;++ks){
      asm volatile("ds_read_b64_tr_b16 %0,%1 offset:%c2":"=&v"(lo[ks]):"v"(vb),"i"(d0*4096+ks*1024):"memory");
      asm volatile("ds_read_b64_tr_b16 %0,%1 offset:%c2":"=&v"(hi[ks]):"v"(vb),"i"(d0*4096+ks*1024+512):"memory");}
    asm volatile("s_waitcnt lgkmcnt(0)":::"memory");SBAR();
    #define PK(k) (bf16x8){lo[k][0],lo[k][1],lo[k][2],lo[k][3],hi[k][0],hi[k][1],hi[k][2],hi[k][3]}
    o[d0]=__builtin_amdgcn_mfma_f32_32x32x16_bf16(pa0,PK(0),o[d0],0,0,0);
    o[d0]=__builtin_amdgcn_mfma_f32_32x32x16_bf16(pa1,PK(1),o[d0],0,0,0);
    o[d0]=__builtin_amdgcn_mfma_f32_32x32x16_bf16(pa2,PK(2),o[d0],0,0,0);
    o[d0]=__builtin_amdgcn_mfma_f32_32x32x16_bf16(pa3,PK(3),o[d0],0,0,0);
    #undef PK
  }
}

#ifndef ATTN_STORE16
#define ATTN_STORE16(p,v) (*(u32x4*)(p)=(v))
#endif
template<int THRL> __device__ __forceinline__ void attn_unit(int b,int kvh,int rb,const bf16*Q,const bf16*__restrict__ K,const bf16*__restrict__ V,char*shm){
  int tid_=threadIdx.x; asm volatile("":"+v"(tid_));
  const int tid=tid_,lane=tid&63,r32=lane&31,hi=lane>>5; const int wid=__builtin_amdgcn_readfirstlane(tid>>6);
  const long rowbase=(long)b*4096; const int q0=rb*64; const int h=kvh*4+(wid>>1);
  const bf16*Qw=Q+(rowbase+q0+(wid&1)*QBLK)*QP+h*D;
  const bf16*Kh=K+rowbase*KP+kvh*D,*Vh=V+rowbase*KP+kvh*D;
  const long metaoff=((long)32768-rowbase)*KP;
  const unsigned lds0=(unsigned)(uintptr_t)shm;
  float*wsf=(float*)(shm+LDS_WS)+wid*64;
  const bf16*ksrc=Kh+(long)lane*KP+wid*8;
  const bf16*vsrc=Vh+(long)(16*(wid&3)+(lane>>2))*KP+(wid>>2)*32+(lane&3)*8;
  const unsigned kdst=lds0+LDS_K+wid*1024, vdst=lds0+LDS_V+wid*1024;
  #define DMA_K(t,slot) glds16(ksrc+((t)<NREAL?(long)(t)*KVBLK*KP:metaoff),(unsigned)__builtin_amdgcn_readfirstlane(kdst+(slot)))
  #define DMA_V(t,slot) glds16(vsrc+((t)<NREAL?(long)(t)*KVBLK*KP:metaoff),(unsigned)__builtin_amdgcn_readfirstlane(vdst+(slot)))
  const int vb0=(int)(lds0+LDS_V)+((lane>>4)&1)*32+(lane&3)*8+(4*hi+((lane&15)>>2))*64;
  const char*Kbase=shm+LDS_K; bf16x8 kf[8];
  const lds_cptr shm3=(lds_cptr)shm; const lds_cptr kp0=shm3+LDS_K+hi*1024+r32*16; const lds_cptr vp0=shm3+LDS_V+((lane>>4)&1)*32+(lane&3)*8+(4*hi+((lane&15)>>2))*64;
  DMA_K(0,0);DMA_V(0,0);DMA_K(1,SLOTB);
  bf16x8 qr[4];
  #pragma unroll
  for(int d0=0;d0<4;++d0)qr[d0]=*reinterpret_cast<const bf16x8*>(&Qw[(long)r32*QP+d0*16+hi*8]);
  float mhat=0.f,l_reg=0.f;f32x16 o[2];o[0]=f32x16{};o[1]=f32x16{};f32x16 negm=f32x16{};asm volatile("":"+v"(negm));
  #define CMASK(P0,P1,t) do{ if((t)==NT-1)mmask(P0,P1); }while(0)
  bool resc=false;
  #define START(P0,P1) do{ const float rm=rowmax(P0,P1); resc=false; \
    { const float dl=rm; mhat=fadd_s(mhat,dl); \
      _Pragma("unroll") for(int r=0;r<16;++r){P0[r]=fsub_s(P0[r],dl);P1[r]=fsub_s(P1[r],dl);} \
      _Pragma("unroll") for(int r=0;r<16;++r)negm[r]=-mhat; asm volatile("":"+v"(negm)); } \
    _Pragma("unroll") for(int r=0;r<16;++r)P0[r]=__builtin_amdgcn_exp2f(P0[r]); }while(0)
  #define RESC() do{ if(resc){ asm volatile("s_waitcnt lgkmcnt(0)":::"memory"); \
      _Pragma("unroll") for(int d_=0;d_<2;++d_) _Pragma("unroll") for(int r=0;r<16;++r)o[d_][r]*=wsf[crow(r,hi)]; } }while(0)
  f32x16 pA0,pA1,pB0,pB1;
  int sl_prev=0,sl_cur=0,sl_next=SLOTB;
  #define ROT() do{sl_prev=sl_cur;sl_cur=sl_next;sl_next=(sl_next==(NSLOT-1)*SLOTB)?0:sl_next+SLOTB;}while(0)
  DMA_K(2,2*SLOTB);
  WAIT_BAR(3);
  qkt(pA0,pA1,Kbase,qr,negm,r32,hi);asm volatile("s_nop 15\n\ts_nop 7":"+v"(pA0),"+v"(pA1));CMASK(pA0,pA1,0);
  START(pA0,pA1);
  _Pragma("unroll") for(int r=0;r<16;++r)pA1[r]=__builtin_amdgcn_exp2f(pA1[r]);
  WAIT_BAR(0);
  DMA_K(3,0);DMA_V(1,SLOTB);
  ROT();
  kload8(kf,kp0+sl_cur);
  WAIT_BAR(2);
  s16x4 vlo[8],vhi[8]; u32x4 pw0,pw1,pw2,pw3;
  #define PKW(P,B) cvtpk_s(P[B],P[B+1])
  #define PAF(k) __builtin_bit_cast(bf16x8,pw##k)
  #define VFR(i) (bf16x8){vlo[i][0],vlo[i][1],vlo[i][2],vlo[i][3],vhi[i][0],vhi[i][1],vhi[i][2],vhi[i][3]}
  #define PIN(x) asm volatile("":"+v"(x))
  #define MX3(a,b,c) __builtin_fmaxf(__builtin_fmaxf((a),(b)),(c))
  #define GAPA(MF,A0,A1,A2,A3,W0,W1,PW) do{ MF; sacc+=A0; sacc+=A1; sacc+=A2; sacc+=A3; PIN(sacc); W0; W1; PIN(PW); SBAR(); }while(0)
  #define EX(v) __builtin_amdgcn_exp2f(v)
  #define GAPB(MF,X,B) do{ MF; X[B]=EX(X[B]); X[B+1]=EX(X[B+1]); X[B+2]=EX(X[B+2]); X[B+3]=EX(X[B+3]); PIN(X); SBAR(); }while(0)
  #define VRD(i) do{ vlo[i]=vtr(vp_+(((i)>>2)*4096+((i)&3)*1024)); vhi[i]=vtr(vp_+(((i)>>2)*4096+((i)&3)*1024+512)); }while(0)
  #define KRD(G,j) do{ if(G){ kload2(kf,kp0+sl_next,j); SBAR(); } }while(0)
  #define STEP(C0,C1,P0,P1,t,GK,GV,GL) do{ SBAR(); \
    const lds_cptr vp_=vp0+sl_prev; \
    VRD(0); SBAR(); float sacc=(P0[0]+P0[1]); \
    GAPA(C0=__builtin_amdgcn_mfma_f32_32x32x16_bf16(kf[0],qr[0],negm,0,0,0), P0[2],P0[3],P0[4],P0[5],     pw0[0]=PKW(P0,0), pw0[1]=PKW(P0,2), pw0); \
    VRD(4); SBAR(); GAPA(C1=__builtin_amdgcn_mfma_f32_32x32x16_bf16(kf[1],qr[0],negm,0,0,0), P0[6],P0[7],P0[8],P0[9],     pw0[2]=PKW(P0,4), pw0[3]=PKW(P0,6), pw0); \
    VRD(1); SBAR(); GAPA(C0=__builtin_amdgcn_mfma_f32_32x32x16_bf16(kf[2],qr[1],C0,0,0,0),   P0[10],P0[11],P0[12],P0[13], pw1[0]=PKW(P0,8), pw1[1]=PKW(P0,10), pw1); \
    VRD(5); SBAR(); GAPA(C1=__builtin_amdgcn_mfma_f32_32x32x16_bf16(kf[3],qr[1],C1,0,0,0),   P0[14],P0[15],P1[0],P1[1],   pw1[2]=PKW(P0,12),pw1[3]=PKW(P0,14), pw1); \
    VRD(2); SBAR(); GAPA(C0=__builtin_amdgcn_mfma_f32_32x32x16_bf16(kf[4],qr[2],C0,0,0,0),   P1[2],P1[3],P1[4],P1[5],     pw2[0]=PKW(P1,0), pw2[1]=PKW(P1,2), pw2); \
    VRD(6); SBAR(); GAPA(C1=__builtin_amdgcn_mfma_f32_32x32x16_bf16(kf[5],qr[2],C1,0,0,0),   P1[6],P1[7],P1[8],P1[9],     pw2[2]=PKW(P1,4), pw2[3]=PKW(P1,6), pw2); \
    VRD(3); SBAR(); GAPA(C0=__builtin_amdgcn_mfma_f32_32x32x16_bf16(kf[6],qr[3],C0,0,0,0),   P1[10],P1[11],P1[12],P1[13], pw3[0]=PKW(P1,8), pw3[1]=PKW(P1,10), pw3); \
    VRD(7); SBAR(); GAPA(C1=__builtin_amdgcn_mfma_f32_32x32x16_bf16(kf[7],qr[3],C1,0,0,0),   P1[14],P1[15],0.f,0.f,       pw3[2]=PKW(P1,12),pw3[3]=PKW(P1,14), pw3); \
    l_reg+=sacc; \
    if(GK){DMA_K((t)+3,sl_cur);} if(GV){DMA_V((t)+1,sl_next);} \
    CMASK(C0,C1,t); \
    { float a=MX3(C0[0],C0[1],C1[0]),b=MX3(C0[2],C0[3],C1[1]); a=MX3(a,C1[2],C1[3]); \
      _Pragma("unroll") for(int r=4;r<16;r+=4){a=MX3(a,C0[r],C0[r+1]);b=MX3(b,C0[r+2],C0[r+3]);a=MX3(a,C1[r],C1[r+1]);b=MX3(b,C1[r+2],C1[r+3]);} \
      float rm=__builtin_fmaxf(a,b); { auto rr=__builtin_amdgcn_permlane32_swap(__float_as_uint(rm),__float_as_uint(rm),false,false); rm=__builtin_fmaxf(__uint_as_float(rr[0]),__uint_as_float(rr[1])); } \
      resc=false; \
      if(__builtin_expect(__any(rm>(float)THRL),0)){ const float dl=__builtin_fmaxf(rm,0.f); mhat+=dl; \
        _Pragma("unroll") for(int r=0;r<16;++r){C0[r]-=dl;C1[r]-=dl;} \
        _Pragma("unroll") for(int r=0;r<16;++r)negm[r]=-mhat; asm volatile("":"+v"(negm)); \
        const float f=__builtin_amdgcn_exp2f(-dl); l_reg*=f; if(hi==0)wsf[r32]=f; resc=true; } } \
    SBAR(); \
    GAPB(o[0]=__builtin_amdgcn_mfma_f32_32x32x16_bf16(PAF(0),VFR(0),o[0],0,0,0), C0,0); \
    GAPB(o[1]=__builtin_amdgcn_mfma_f32_32x32x16_bf16(PAF(0),VFR(4),o[1],0,0,0), C0,4); \
    KRD(GL,0); GAPB(o[0]=__builtin_amdgcn_mfma_f32_32x32x16_bf16(PAF(1),VFR(1),o[0],0,0,0), C0,8); \
    KRD(GL,1); GAPB(o[1]=__builtin_amdgcn_mfma_f32_32x32x16_bf16(PAF(1),VFR(5),o[1],0,0,0), C0,12); \
    KRD(GL,2); GAPB(o[0]=__builtin_amdgcn_mfma_f32_32x32x16_bf16(PAF(2),VFR(2),o[0],0,0,0), C1,0); \
    KRD(GL,3); GAPB(o[1]=__builtin_amdgcn_mfma_f32_32x32x16_bf16(PAF(2),VFR(6),o[1],0,0,0), C1,4); \
    GAPB(o[0]=__builtin_amdgcn_mfma_f32_32x32x16_bf16(PAF(3),VFR(3),o[0],0,0,0), C1,8); \
    GAPB(o[1]=__builtin_amdgcn_mfma_f32_32x32x16_bf16(PAF(3),VFR(7),o[1],0,0,0), C1,12); \
    }while(0)
  int t=1;
  #undef CMASK
  #define CMASK(P0,P1,t) do{}while(0)
  for(;t+5<NT;t+=2){
    STEP(pB0,pB1,pA0,pA1,t,true,true,true);     WAIT_BAR(2); RESC(); ROT();
    STEP(pA0,pA1,pB0,pB1,t+1,true,true,true);   WAIT_BAR(2); RESC(); ROT();
  }
  #undef CMASK
  #define CMASK(P0,P1,t) do{ if((t)==NT-1)mmask(P0,P1); }while(0)
  #define ENDW(tt) do{ if((tt)+3<NT){WAIT_BAR(2);} else if((tt)+2<NT){WAIT_BAR(1);} else {WAIT_BAR(0);} }while(0)
  for(;t+2<NT;t+=2){
    STEP(pB0,pB1,pA0,pA1,t,(t+3<NT),(t+1<NT),(t+1<NT));       ENDW(t);   RESC(); ROT();
    STEP(pA0,pA1,pB0,pB1,t+1,(t+4<NT),(t+2<NT),(t+2<NT));     ENDW(t+1); RESC(); ROT();
  }
  STEP(pB0,pB1,pA0,pA1,NT-2,false,true,true); WAIT_BAR(0); RESC(); ROT();
  STEP(pA0,pA1,pB0,pB1,NT-1,false,false,false); RESC();
  { float sacc=pA0[0]+pA0[1]; _Pragma("unroll") for(int r=2;r<16;++r)sacc+=pA0[r]; _Pragma("unroll") for(int r=0;r<16;++r)sacc+=pA1[r]; l_reg+=sacc;
    pw0=(u32x4){PKW(pA0,0),PKW(pA0,2),PKW(pA0,4),PKW(pA0,6)};pw1=(u32x4){PKW(pA0,8),PKW(pA0,10),PKW(pA0,12),PKW(pA0,14)};pw2=(u32x4){PKW(pA1,0),PKW(pA1,2),PKW(pA1,4),PKW(pA1,6)};pw3=(u32x4){PKW(pA1,8),PKW(pA1,10),PKW(pA1,12),PKW(pA1,14)};
    SBAR(); pv(o,vb0+sl_cur,PAF(0),PAF(1),PAF(2),PAF(3)); }
  #undef PKW
  #undef PAF
  #undef VFR
  #undef PIN
  #undef MX3
  #undef GAPA
  #undef GAPB
  #undef EX
  #undef VRD
  #undef KRD
  #undef STEP
  #undef ENDW
  {auto rr=__builtin_amdgcn_permlane32_swap(__float_as_uint(l_reg),__float_as_uint(l_reg),false,false);l_reg=__uint_as_float(rr[0])+__uint_as_float(rr[1]);}
  if(hi==0)wsf[32+r32]=l_reg;asm volatile("s_waitcnt lgkmcnt(0)":::"memory");
  float rli[16];
  #pragma unroll
  for(int r=0;r<16;++r)rli[r]=__builtin_amdgcn_rcpf(wsf[32+crow(r,hi)]);
  { char*ob=shm+LDS_OB+((wid&1)*QBLK)*OB_PITCH+h*128;
    #pragma unroll
    for(int r=0;r<16;++r){const int orow=crow(r,hi);
      #pragma unroll
      for(int d0=0;d0<2;++d0)*(bf16*)(ob+orow*OB_PITCH+(d0*32+r32)*2)=__float2bfloat16(o[d0][r]*rli[r]);} }
  asm volatile("s_waitcnt lgkmcnt(0)\n\ts_barrier":::"memory");
  #undef DMA_K
  #undef DMA_V
  #undef CMASK
  #undef START
  #undef RESC
  #undef ROT
}
constexpr int ATTN_LDS_BYTES=LDS_BYTES;
__device__ __forceinline__ void attn_rows_out(long m0,const float*gain,unsigned short*MIX,char*shm){
  int tid_=threadIdx.x; asm volatile("":"+v"(tid_));
  const int tid=tid_,lane=tid&63; const int wid=__builtin_amdgcn_readfirstlane(tid>>6);
  const f32x4v g0=*(const f32x4v*)(gain+lane*8),g1=*(const f32x4v*)(gain+lane*8+4);
  #pragma unroll
  for(int i=0;i<8;++i){ const int row=wid*8+i;
    const u32x4 v=*(const u32x4*)(shm+LDS_OB+row*OB_PITCH+lane*16);
    float f[8]; f[0]=__uint_as_float(v[0]<<16);f[1]=__uint_as_float(v[0]&0xffff0000u);f[2]=__uint_as_float(v[1]<<16);f[3]=__uint_as_float(v[1]&0xffff0000u);
    f[4]=__uint_as_float(v[2]<<16);f[5]=__uint_as_float(v[2]&0xffff0000u);f[6]=__uint_as_float(v[3]<<16);f[7]=__uint_as_float(v[3]&0xffff0000u);
    float ss=0.f;
    #pragma unroll
    for(int j=0;j<8;++j)ss+=f[j]*f[j];
    #pragma unroll
    for(int o_=1;o_<64;o_<<=1)ss+=__shfl_xor(ss,o_);
    const float rs=1.0f/sqrtf(ss*(1.f/512.f)+1e-6f);
    u32x4 w; w[0]=cvtpk_s(f[0]*rs*g0[0],f[1]*rs*g0[1]); w[1]=cvtpk_s(f[2]*rs*g0[2],f[3]*rs*g0[3]); w[2]=cvtpk_s(f[4]*rs*g1[0],f[5]*rs*g1[1]); w[3]=cvtpk_s(f[6]*rs*g1[2],f[7]*rs*g1[3]);
    *(u32x4*)(MIX+(m0+row)*1024+lane*8)=w; }
  asm volatile("s_waitcnt lgkmcnt(0)\n\ts_barrier":::"memory");
}
template<int THRL=8> __device__ __forceinline__ void attn_phase(char*lds,const bf16*Q,const bf16*K,const bf16*V,const float*gain,unsigned short*MIX,int vcu,int ncu){
  for(int blk=vcu;blk<512;blk+=ncu){ const int b=blk>>6, rb=blk&63;
    attn_unit<THRL>(b,0,rb,Q,K,V,lds); attn_unit<THRL>(b,1,rb,Q,K,V,lds);
    attn_rows_out((long)b*4096+rb*64,gain,MIX,lds); }
}
#undef SBAR
#undef WAIT_BAR
}

__device__ __forceinline__ void pool_phase(LAS unsigned char* lds, const bf16_t* U, const bf16_t* WPT, const float* pscale, bf16_t* MIX) {
    int tid_ = threadIdx.x; asm volatile("" : "+v"(tid_));
    const int tid = tid_, lane = tid & 63, wid = __builtin_amdgcn_readfirstlane(tid >> 6);
    const int fr = lane & 15, fq = lane >> 4;
    constexpr int PITCH = 1040;
    LAS float* red = (LAS float*)(lds + 80 * PITCH);
    const int mt = wid & 3, gsel = wid >> 2;
    for (int blk = blockIdx.x; blk < MR / 64; blk += gridDim.x) {
        const int m0 = blk * 64, b = m0 >> 12, s0 = m0 & (SEQ - 1);
#pragma unroll
        for (int i = 0; i < 10; ++i) {
            const int idx = i * 512 + tid, row = idx >> 6, c = idx & 63, p = s0 - 8 + row;
            u32x4 v = (u32x4){0u, 0u, 0u, 0u};
            if (p < SEQ) { const int grow = p >= 0 ? b * SEQ + p : MR + NMETA + p; v = *(const u32x4*)(U + (size_t)grow * DPOOL + c * 8); }
            *(LAS u32x4*)(lds + row * PITCH + c * 16) = v;
        }
        __syncthreads();
        f32x4 acc[2][8];
#pragma unroll
        for (int gi = 0; gi < 2; ++gi)
#pragma unroll
            for (int nt = 0; nt < 8; ++nt) acc[gi][nt] = (f32x4){0.f, 0.f, 0.f, 0.f};
        const int tl = mt * 16 + fr;
#pragma unroll
        for (int gi = 0; gi < 2; ++gi) {
            const int g = gi == 0 ? gsel : 3 - gsel, w2 = 1 << g;
            int cnt = SEQ - (s0 + tl) + w2; cnt = cnt < 2 * w2 ? cnt : 2 * w2;
            const float inv = 1.0f / (float)cnt;
            for (int ks = 0; ks < 4; ++ks) {
                pg8::bf16x8 bfr[8];
#pragma unroll
                for (int nt = 0; nt < 8; ++nt) bfr[nt] = *(const pg8::bf16x8*)(WPT + ((size_t)(g * 128 + nt * 16 + fr) * 128 + ks * 32 + 8 * fq));
                const int chb = g * 128 + ks * 32 + 8 * fq;
                float sum[8];
#pragma unroll
                for (int j = 0; j < 8; ++j) sum[j] = 0.f;
                LAS const unsigned char* base = lds + (tl + 8 - w2) * PITCH + chb * 2;
#pragma unroll 2
                for (int r = 0; r < 2 * w2; ++r) {
                    const u32x4 v = *(LAS const u32x4*)(base + r * PITCH);
                    sum[0] += __uint_as_float(v.x << 16); sum[1] += __uint_as_float(v.x & 0xffff0000u); sum[2] += __uint_as_float(v.y << 16); sum[3] += __uint_as_float(v.y & 0xffff0000u);
                    sum[4] += __uint_as_float(v.z << 16); sum[5] += __uint_as_float(v.z & 0xffff0000u); sum[6] += __uint_as_float(v.w << 16); sum[7] += __uint_as_float(v.w & 0xffff0000u);
                }
                const u32x4 sv = *(LAS const u32x4*)(lds + (tl + 8) * PITCH + chb * 2);
                u32x4 aw;
                aw.x = pg8::cvt_pk_bf16(sum[0] * inv - __uint_as_float(sv.x << 16), sum[1] * inv - __uint_as_float(sv.x & 0xffff0000u));
                aw.y = pg8::cvt_pk_bf16(sum[2] * inv - __uint_as_float(sv.y << 16), sum[3] * inv - __uint_as_float(sv.y & 0xffff0000u));
                aw.z = pg8::cvt_pk_bf16(sum[4] * inv - __uint_as_float(sv.z << 16), sum[5] * inv - __uint_as_float(sv.z & 0xffff0000u));
                aw.w = pg8::cvt_pk_bf16(sum[6] * inv - __uint_as_float(sv.w << 16), sum[7] * inv - __uint_as_float(sv.w & 0xffff0000u));
                const pg8::bf16x8 a = __builtin_bit_cast(pg8::bf16x8, aw);
#pragma unroll
                for (int nt = 0; nt < 8; ++nt) acc[gi][nt] = __builtin_amdgcn_mfma_f32_16x16x32_bf16(a, bfr[nt], acc[gi][nt], 0, 0, 0);
            }
        }
        float ps[4];
#pragma unroll
        for (int reg = 0; reg < 4; ++reg) { float s = 0.f;
#pragma unroll
            for (int gi = 0; gi < 2; ++gi)
#pragma unroll
                for (int nt = 0; nt < 8; ++nt) s += acc[gi][nt][reg] * acc[gi][nt][reg];
            s += __shfl_xor(s, 1); s += __shfl_xor(s, 2); s += __shfl_xor(s, 4); s += __shfl_xor(s, 8);
            ps[reg] = s; }
        if (fr == 0) {
#pragma unroll
            for (int reg = 0; reg < 4; ++reg) red[(mt * 16 + fq * 4 + reg) * 2 + gsel] = ps[reg];
        }
        __syncthreads();
        float rs[4];
#pragma unroll
        for (int reg = 0; reg < 4; ++reg) { const int row = mt * 16 + fq * 4 + reg; rs[reg] = 1.0f / sqrtf((red[row * 2] + red[row * 2 + 1]) * (1.f / DPOOL) + EPS); }
#pragma unroll
        for (int gi = 0; gi < 2; ++gi) {
            const int g = gi == 0 ? gsel : 3 - gsel;
#pragma unroll
            for (int nt = 0; nt < 8; ++nt) {
                const int ch = g * 128 + nt * 16 + fr; const float sc = pscale[ch];
#pragma unroll
                for (int reg = 0; reg < 4; ++reg) *(LAS bf16_t*)(lds + (mt * 16 + fq * 4 + reg) * PITCH + ch * 2) = (bf16_t)f2bf(acc[gi][nt][reg] * rs[reg] * sc);
            }
        }
        __syncthreads();
#pragma unroll
        for (int i = 0; i < 8; ++i) {
            const int idx = i * 512 + tid, row = idx >> 6, c = idx & 63;
            const u32x4 v = *(LAS const u32x4*)(lds + row * PITCH + c * 16);
            *(u32x4*)(MIX + (size_t)(m0 + row) * DM + DATT + c * 8) = v;
        }
        __syncthreads();
    }
}

__device__ __forceinline__ void final_norm(float* out, const float* ssq, const float* g) {
    int tid_ = threadIdx.x; asm volatile("" : "+v"(tid_));
    const int lane = tid_ & 63, gw = blockIdx.x * 8 + (tid_ >> 6), NGW = gridDim.x * 8;
    f32x4 gv[4];
#pragma unroll
    for (int j = 0; j < 4; ++j) gv[j] = *((const f32x4*)g + lane + 64 * j);
    for (int m = gw; m < MR; m += NGW) {
        float t = 0.f;
#pragma unroll
        for (int i = 0; i < 16; ++i) t += ssq[(size_t)m * 16 + i];
        const float rs = 1.0f / sqrtf(t * (1.f / DM) + EPS);
        f32x4* xr = (f32x4*)(out + (size_t)m * DM) + lane;
#pragma unroll
        for (int j = 0; j < 4; ++j) xr[64 * j] = xr[64 * j] * rs * gv[j];
    }
}

__global__ void __launch_bounds__(NTHREADS, 2) fwd_kernel(Args args) {
    extern __shared__ __attribute__((aligned(16))) unsigned char lds_raw[];
    float* lds = (float*)lds_raw;
    cg::grid_group grid = cg::this_grid();
    unsigned char* ws = args.ws;
    const float* x = args.in[0]; const float* meta = args.in[1]; const float* norm_mix = args.in[2]; const float* w_in = args.in[3];
    const float* q_norm = args.in[4]; const float* k_norm = args.in[5]; const float* attn_out_norm = args.in[6]; const float* w_pool = args.in[7];
    const float* pool_scale = args.in[8]; const float* w_out = args.in[9]; const float* norm_ffn = args.in[10]; const float* w_ffn_in = args.in[11];
    const float* w_ffn_down = args.in[12]; const float* norm_final = args.in[13];
    float* rope = (float*)(ws + WS_ROPE);
    bf16_t* HN = (bf16_t*)(ws + WS_HN); bf16_t* Q = (bf16_t*)(ws + WS_Q); bf16_t* K = (bf16_t*)(ws + WS_K); bf16_t* V = (bf16_t*)(ws + WS_V);
    bf16_t* U = (bf16_t*)(ws + WS_U); bf16_t* MIX = (bf16_t*)(ws + WS_MIX); bf16_t* A2 = (bf16_t*)(ws + WS_A2); bf16_t* ACT = (bf16_t*)(ws + WS_ACT);
    float* SSQ2 = (float*)(ws + WS_SSQ2); float* SSQ3 = (float*)(ws + WS_SSQ3);

    bf16_t* WIN = (bf16_t*)(ws + WS_WIN); bf16_t* WOUT = (bf16_t*)(ws + WS_WOUT); bf16_t* WFI = (bf16_t*)(ws + WS_WFI); bf16_t* WFD = (bf16_t*)(ws + WS_WFD);
    LAS unsigned char* ldsl = (LAS unsigned char*)lds_raw;
    rope_table(rope);
    bf16_t* WPT = (bf16_t*)(ws + WS_WPOOL);
    convert_weights(ldsl, w_in, w_out, w_ffn_in, norm_ffn, w_ffn_down, WIN, WOUT, WFI, WFD, w_pool, WPT);
    rms_rows_p0(x, meta, norm_mix, HN);
    grid.sync();
    { pg8::Gemm g{HN, WIN, MP, DIN, DM}; pg8::StaticOrder S; S.init(MP, DIN, (int)gridDim.x, (int)blockIdx.x); EpiInG e{q_norm, k_norm, rope, Q, K, V, U};
      pg8::gemm_phase<EpiInG, pg8::StaticOrder, PG8_ALIGN, PG8_SP2>(ldsl, g, S, e); }
    grid.sync();
    { const int G = (int)gridDim.x, bx = (int)blockIdx.x; const int vcu = (G % 8 == 0) ? (bx % 8) * (G / 8) + bx / 8 : bx;
      attn_body::attn_phase<8>((char*)lds_raw, (const attn_body::bf16*)Q, (const attn_body::bf16*)K, (const attn_body::bf16*)V, attn_out_norm, MIX, vcu, G); }
    pool_phase(ldsl, U, WPT, pool_scale, MIX);
    grid.sync();
    { pg8::Gemm g{MIX, WOUT, MR, DM, DM}; pg8::StaticOrder S; S.init(MR, DM, (int)gridDim.x, (int)blockIdx.x); EpiOutG e{x, args.out, A2, SSQ2};
      pg8::gemm_phase<EpiOutG, pg8::StaticOrder, PG8_ALIGN, PG8_SP2>(ldsl, g, S, e); }
    grid.sync();
    { pg8::Gemm g{A2, WFI, MR, 2 * DFF, DM}; pg8::StaticOrder S; S.init(MR, 2 * DFF, (int)gridDim.x, (int)blockIdx.x); EpiFfnInG e{SSQ2, ACT};
      pg8::gemm_phase<EpiFfnInG, pg8::StaticOrder, PG8_ALIGN, PG8_SP2>(ldsl, g, S, e); }
    grid.sync();
    { pg8::Gemm g{ACT, WFD, MR, DM, DFF}; pg8::StaticOrder S; S.init(MR, DM, (int)gridDim.x, (int)blockIdx.x); EpiDownG e{args.out, SSQ3};
      pg8::gemm_phase<EpiDownG, pg8::StaticOrder, PG8_ALIGN, PG8_SP2>(ldsl, g, S, e); }
    grid.sync();
    final_norm(args.out, SSQ3, norm_final);
}

extern "C" void kernel_launch(void* const* d_in, const int* in_sizes, int n_in, void* d_out, int out_size, void* d_ws, size_t ws_size, hipStream_t stream) {
    static int grid = 0;
    if (grid == 0) {
        int dev = 0, cus = 0, per_cu = 0;
        hipGetDevice(&dev);
        hipDeviceGetAttribute(&cus, hipDeviceAttributeMultiprocessorCount, dev);
        hipFuncSetAttribute((const void*)fwd_kernel, hipFuncAttributeMaxDynamicSharedMemorySize, LDS_BYTES);
        hipOccupancyMaxActiveBlocksPerMultiprocessor(&per_cu, (const void*)fwd_kernel, NTHREADS, LDS_BYTES);
        if (per_cu < 1) { fprintf(stderr, "kernel_launch: occupancy query says %d blocks per CU\n", per_cu); per_cu = 1; }
        (void)hipGetLastError();
        grid = cus;
    }
    Args a{};
    for (int i = 0; i < 14; ++i) a.in[i] = (const float*)d_in[i];
    a.out = (float*)d_out; a.ws = (unsigned char*)d_ws;
    void* params[] = {&a};
    hipError_t e = hipLaunchCooperativeKernel((const void*)fwd_kernel, dim3(grid), dim3(NTHREADS), params, LDS_BYTES, stream);
    if (e != hipSuccess) fprintf(stderr, "cooperative launch failed: %s (grid %d)\n", hipGetErrorString(e), grid);
}
```

```cpp
#include <hip/hip_runtime.h>
#include <hip/hip_cooperative_groups.h>
#include <cstdio>
#include <cstdint>
namespace cg = cooperative_groups;

typedef unsigned short bf16_t;
typedef float f32x4 __attribute__((ext_vector_type(4)));
typedef unsigned u32x4 __attribute__((ext_vector_type(4)));

constexpr int NB = 8, SEQ = 4096, DM = 1024, NMETA = 16;
constexpr int MR = NB * SEQ;
constexpr int MP = 33024;
constexpr int DATT = 512, DKV = 128, DPOOL = 512, DIN = 1280, DFF = 2816;
constexpr int LKEYS = SEQ + NMETA;
constexpr float EPS = 1e-6f;
constexpr float C2 = 0.125f * 1.4426950408889634f;

constexpr size_t MiB = 1u << 20;
constexpr size_t WS_ROPE = 1 * MiB;
constexpr size_t WS_WIN = 2 * MiB, WS_WOUT = 5 * MiB, WS_WFI = 7 * MiB, WS_WFD = 18 * MiB, WS_WPOOL = 23 * MiB + 512 * 1024;
constexpr size_t WS_HN = 24 * MiB;
constexpr size_t WS_Q = 89 * MiB;
constexpr size_t WS_K = 122 * MiB;
constexpr size_t WS_V = 131 * MiB;
constexpr size_t WS_U = 140 * MiB;
constexpr size_t WS_MIX = 173 * MiB;
constexpr size_t WS_A2 = 237 * MiB;
constexpr size_t WS_SSQ2 = 301 * MiB;
constexpr size_t WS_SSQ3 = 303 * MiB;
constexpr size_t WS_ACT = 24 * MiB;

constexpr int NTHREADS = 512;
constexpr int LDS_BYTES = 147456;

struct Args { const float* in[14]; float* out; unsigned char* ws; };

__device__ __forceinline__ unsigned f2bf(float f) { unsigned u = __builtin_bit_cast(unsigned, f); return (u + 0x7fffu + ((u >> 16) & 1u)) >> 16; }
__device__ __forceinline__ float bf2f(unsigned h) { return __builtin_bit_cast(float, h << 16); }
__device__ __forceinline__ unsigned pk2(float lo, float hi) { return f2bf(lo) | (f2bf(hi) << 16); }
__device__ __forceinline__ float wave_sum(float v) {
#pragma unroll
    for (int o = 1; o < 64; o <<= 1) v += __shfl_xor(v, o);
    return v;
}
__device__ __forceinline__ float wave_max(float v) {
#pragma unroll
    for (int o = 1; o < 64; o <<= 1) v = fmaxf(v, __shfl_xor(v, o));
    return v;
}

namespace pg8 {
#define PG8_LAS __attribute__((address_space(3)))
typedef unsigned short bf16_t;
typedef short bf16x8 __attribute__((ext_vector_type(8)));
typedef float f32x4 __attribute__((ext_vector_type(4)));
typedef unsigned u32x4 __attribute__((ext_vector_type(4)));
constexpr int BM = 256, BK = 64, HALF = 128, HTB = HALF * BK * 2  , STAGE_BYTES = 8 * HTB, NXCD = 8, WGM = 8;

__host__ __device__ __forceinline__ int lds_byte(int r, int c) { const int st = (r >> 4) * 2 + (c >> 5), rr = r & 15, cc = c & 31, ob = rr * 64 + cc * 2; return st * 1024 + (ob ^ (((ob >> 9) & 1) << 5)); }
__host__ __device__ __forceinline__ void stage_rc(int b, int& R, int& C) { const int st = b / 1024, sb = b % 1024, swz = sb ^ (((sb >> 9) & 1) << 5); R = (st >> 1) * 16 + swz / 64; C = (st & 1) * 32 + (swz % 64) / 2; }
__host__ __device__ __forceinline__ int perm32(int rho) { const int n = rho >> 4, i = rho & 15; return 8 * (i >> 2) + 4 * n + (i & 3); }

struct Unit { int pm, pn; };
struct Gemm { const bf16_t* A; const bf16_t* Bt; int M, N, K; };

struct StaticOrder {
    int nM, nN, nwg, G, c;
    __host__ __device__ void init(int M, int N, int G_, int c_) { nM = M / BM; nN = N / BM; nwg = nM * nN; G = G_; c = c_; }
    __host__ __device__ bool next(int i, Unit& u) const {
        const long L = (long)i * G + c; if (L >= nwg) return false;
        int wgid = (int)L; { const int q = nwg / NXCD, r = nwg % NXCD, xcd = wgid % NXCD, off = wgid / NXCD; wgid = (xcd < r ? xcd * (q + 1) : r * (q + 1) + (xcd - r) * q) + off; }
        const int nig = WGM * nN, gid = wgid / nig, fm = gid * WGM, gsz = (nM - fm) < WGM ? (nM - fm) : WGM;
        u.pm = fm + ((wgid % nig) % gsz); u.pn = (wgid % nig) / gsz; return true;
    }
    __device__ __forceinline__ void a_ready(const Unit&) const {}
    __device__ __forceinline__ void done(const Unit&) const {}
};

__device__ __forceinline__ unsigned cvt_pk_bf16(float lo, float hi) { unsigned r; asm volatile("v_cvt_pk_bf16_f32 %0, %1, %2" : "=v"(r) : "v"(lo), "v"(hi)); return r; }
typedef float f32x2 __attribute__((ext_vector_type(2)));
template <class Epi, class Sched, bool ALIGN_EPI = false, bool SP2 = false>
__device__ __forceinline__ void gemm_phase(PG8_LAS unsigned char* lds, const Gemm g, const Sched& S, const Epi& E) {
    int tid_ = threadIdx.x; asm volatile("" : "+v"(tid_));
    const int tid = tid_, wid = __builtin_amdgcn_readfirstlane(tid >> 6), lane = tid & 63, wr = wid >> 2, wc = wid & 3, fr = lane & 15, fq = lane >> 4;
    const int K = g.K, nt = K / BK;
    unsigned voffA[2], voffB[2];
#pragma unroll
    for (int i = 0; i < 2; ++i) { int R, C; stage_rc(tid * 16 + i * 8192, R, C); const int Rb = Epi::PERM ? ((R & ~31) + perm32(R & 31)) : R;
        voffA[i] = (unsigned)(R * K + C) * 2u; voffB[i] = (unsigned)(Rb * K + C) * 2u; }
    const size_t kstep = (size_t)(BK * 2);
    const size_t hstep = (size_t)HALF * K * 2;
    const size_t tstep = 2 * hstep;
    const unsigned ldsw = (unsigned)wid * 1024u;
    const int aoff = lds_byte(wr * 64 + fr, fq * 8), boff = lds_byte(wc * 32 + fr, fq * 8);
#define PG8_SA(b, h) (((b) * 2 + (h)) * HTB)
#define PG8_SB(b, h) ((4 + (b) * 2 + (h)) * HTB)
#define PG8_STAGE(bufoff, gbase, voff) do { _Pragma("unroll") for (int _i = 0; _i < 2; ++_i) \
        __builtin_amdgcn_global_load_lds((const unsigned*)((const char*)(gbase) + (voff)[_i]), (PG8_LAS unsigned*)(lds + (bufoff) + ldsw + _i * 8192), 16, 0, 0); } while (0)
#define PG8_LDA(dst, b, h) do { _Pragma("unroll") for (int m = 0; m < 4; ++m) _Pragma("unroll") for (int k = 0; k < 2; ++k) dst[m][k] = *(const PG8_LAS bf16x8*)(lds + PG8_SA(b, h) + aoff + m * 2048 + k * 1024); } while (0)
#define PG8_LDB(dst, b, h) do { _Pragma("unroll") for (int n = 0; n < 2; ++n) _Pragma("unroll") for (int k = 0; k < 2; ++k) dst[n][k] = *(const PG8_LAS bf16x8*)(lds + PG8_SB(b, h) + boff + n * 2048 + k * 1024); } while (0)
#define PG8_MMA(ai, bj, At, Bt) do { __builtin_amdgcn_s_setprio(1); _Pragma("unroll") for (int m = 0; m < 4; ++m) _Pragma("unroll") for (int n = 0; n < 2; ++n) _Pragma("unroll") for (int k = 0; k < 2; ++k) \
        acc[ai][bj][m][n] = __builtin_amdgcn_mfma_f32_16x16x32_bf16(Bt[n][k], At[m][k], acc[ai][bj][m][n], 0, 0, 0); __builtin_amdgcn_s_setprio(0); } while (0)
#define PG8_WAIT_V(n) asm volatile("s_waitcnt vmcnt(" #n ")" ::: "memory")
#define PG8_WAIT_L(n) asm volatile("s_waitcnt lgkmcnt(" #n ")" ::: "memory")
#define PG8_BAR __builtin_amdgcn_s_barrier()
#define PG8_SCHED __builtin_amdgcn_sched_barrier(0)
    Unit cur, nxt; int ui = 0;
    if (!S.next(0, cur)) return;
    f32x4 acc[2][2][4][2];
#pragma unroll
    for (int a = 0; a < 2; ++a)
#pragma unroll
        for (int b = 0; b < 2; ++b)
#pragma unroll
            for (int m = 0; m < 4; ++m)
#pragma unroll
                for (int n = 0; n < 2; ++n) acc[a][b][m][n] = (f32x4){0.f, 0.f, 0.f, 0.f};
    bf16x8 At[4][2], B0[2][2], B1[2][2];
    const char* cA = (const char*)g.A + (size_t)cur.pm * tstep; const char* cB = (const char*)g.Bt + (size_t)cur.pn * tstep;
    S.a_ready(cur);
    if constexpr (SP2) {
        PG8_STAGE(PG8_SB(0, 0), cB, voffB); PG8_STAGE(PG8_SB(0, 1), cB + hstep, voffB); PG8_STAGE(PG8_SA(0, 0), cA, voffA); PG8_STAGE(PG8_SA(0, 1), cA + hstep, voffA);
        if (wr == 1) PG8_BAR;
        PG8_WAIT_V(2); PG8_BAR;
        PG8_STAGE(PG8_SB(1, 0), cB + kstep, voffB); PG8_STAGE(PG8_SA(1, 0), cA + kstep, voffA); PG8_STAGE(PG8_SB(1, 1), cB + hstep + kstep, voffB);
        PG8_WAIT_V(6); PG8_BAR;
    } else {
        PG8_STAGE(PG8_SB(0, 0), cB, voffB); PG8_STAGE(PG8_SA(0, 0), cA, voffA); PG8_STAGE(PG8_SB(0, 1), cB + hstep, voffB); PG8_STAGE(PG8_SA(0, 1), cA + hstep, voffA);
        if (wr == 1) PG8_BAR;
        PG8_WAIT_V(4); PG8_BAR;
        PG8_STAGE(PG8_SB(1, 0), cB + kstep, voffB); PG8_STAGE(PG8_SA(1, 0), cA + kstep, voffA); PG8_STAGE(PG8_SB(1, 1), cB + hstep + kstep, voffB);
        PG8_WAIT_V(6); PG8_BAR;
    }
    for (;;) {
        const bool has_next = S.next(ui + 1, nxt);
        const char* nA = has_next ? (const char*)g.A + (size_t)nxt.pm * tstep : cA; const char* nB = has_next ? (const char*)g.Bt + (size_t)nxt.pn * tstep : cB;
        for (int t = 0; t < nt; t += 2) {
            const bool last = (t == nt - 2);
            const char* a1 = cA + (size_t)(t + 1) * kstep;
            const char* a2 = last ? nA : cA + (size_t)(t + 2) * kstep; const char* b2 = last ? nB : cB + (size_t)(t + 2) * kstep;
            const char* a3 = a2 + kstep; const char* b3 = b2 + kstep;
            if (last && has_next) S.a_ready(nxt);
            if constexpr (SP2) {
            PG8_LDB(B0, 0, 0); PG8_LDB(B1, 0, 1); PG8_SCHED; PG8_LDA(At, 0, 0); PG8_STAGE(PG8_SA(1, 1), a1 + hstep, voffA);
            PG8_WAIT_V(8); PG8_WAIT_L(0); PG8_BAR; PG8_MMA(0, 0, At, B0); PG8_MMA(0, 1, At, B1); PG8_BAR; PG8_SCHED;
            PG8_LDA(At, 0, 1); PG8_STAGE(PG8_SB(0, 0), b2, voffB); PG8_STAGE(PG8_SB(0, 1), b2 + hstep, voffB); PG8_STAGE(PG8_SA(0, 0), a2, voffA);
            PG8_WAIT_V(8); PG8_WAIT_L(0); PG8_BAR; PG8_MMA(1, 0, At, B0); PG8_MMA(1, 1, At, B1); PG8_BAR; PG8_SCHED;
            PG8_LDB(B0, 1, 0); PG8_LDB(B1, 1, 1); PG8_SCHED; PG8_LDA(At, 1, 0); PG8_STAGE(PG8_SA(0, 1), a2 + hstep, voffA);
            PG8_WAIT_V(8); PG8_WAIT_L(0); PG8_BAR; PG8_MMA(0, 0, At, B0); PG8_MMA(0, 1, At, B1); PG8_BAR; PG8_SCHED;
            PG8_LDA(At, 1, 1); PG8_STAGE(PG8_SB(1, 0), b3, voffB); PG8_STAGE(PG8_SB(1, 1), b3 + hstep, voffB); PG8_STAGE(PG8_SA(1, 0), a3, voffA);
            PG8_WAIT_V(8); PG8_WAIT_L(0); PG8_BAR; PG8_MMA(1, 0, At, B0); PG8_MMA(1, 1, At, B1); PG8_BAR; PG8_SCHED;
            } else {
            PG8_LDB(B0, 0, 0); PG8_SCHED; PG8_LDA(At, 0, 0); PG8_STAGE(PG8_SA(1, 1), a1 + hstep, voffA);
            PG8_WAIT_L(8); PG8_BAR; PG8_WAIT_L(0); PG8_MMA(0, 0, At, B0); PG8_BAR; PG8_SCHED;
            PG8_LDB(B1, 0, 1); PG8_STAGE(PG8_SB(0, 0), b2, voffB);
            PG8_BAR; PG8_WAIT_L(0); PG8_MMA(0, 1, At, B1); PG8_BAR;
            PG8_LDA(At, 0, 1); PG8_STAGE(PG8_SA(0, 0), a2, voffA);
            PG8_BAR; PG8_WAIT_L(0); PG8_MMA(1, 0, At, B0); PG8_BAR; PG8_SCHED;
            PG8_STAGE(PG8_SB(0, 1), b2 + hstep, voffB);
            PG8_WAIT_V(6); PG8_BAR; PG8_MMA(1, 1, At, B1); PG8_BAR;
            PG8_LDB(B0, 1, 0); PG8_SCHED; PG8_LDA(At, 1, 0); PG8_STAGE(PG8_SA(0, 1), a2 + hstep, voffA);
            PG8_WAIT_L(8); PG8_BAR; PG8_WAIT_L(0); PG8_MMA(0, 0, At, B0); PG8_BAR; PG8_SCHED;
            PG8_LDB(B1, 1, 1); PG8_STAGE(PG8_SB(1, 0), b3, voffB);
            PG8_BAR; PG8_WAIT_L(0); PG8_MMA(0, 1, At, B1); PG8_BAR;
            PG8_LDA(At, 1, 1); PG8_STAGE(PG8_SA(1, 0), a3, voffA);
            PG8_BAR; PG8_WAIT_L(0); PG8_MMA(1, 0, At, B0); PG8_BAR; PG8_SCHED;
            PG8_STAGE(PG8_SB(1, 1), b3 + hstep, voffB);
            PG8_WAIT_V(6); PG8_BAR; PG8_MMA(1, 1, At, B1); PG8_BAR;
            }
        }
        if constexpr (ALIGN_EPI) { if (wr == 0) PG8_BAR; }
        if constexpr (!Epi::AFTER_DRAIN) { E(acc, cur, wr, wc, fr, fq); S.done(cur); }
        if (!has_next) break;
#pragma unroll
        for (int a = 0; a < 2; ++a)
#pragma unroll
            for (int b = 0; b < 2; ++b)
#pragma unroll
                for (int m = 0; m < 4; ++m)
#pragma unroll
                    for (int n = 0; n < 2; ++n) acc[a][b][m][n] = (f32x4){0.f, 0.f, 0.f, 0.f};
        cur = nxt; cA = nA; cB = nB; ++ui;
        if constexpr (ALIGN_EPI) { if (wr == 1) PG8_BAR; }
    }
    PG8_WAIT_V(0);
    if constexpr (!ALIGN_EPI) { if (wr == 0) PG8_BAR; }
    PG8_BAR;
    if constexpr (Epi::AFTER_DRAIN) { E.fused(acc, cur, wr, wc, fr, fq, lds, wid, lane); S.done(cur); }
#undef PG8_SA
#undef PG8_SB
#undef PG8_STAGE
#undef PG8_LDA
#undef PG8_LDB
#undef PG8_MMA
#undef PG8_WAIT_V
#undef PG8_WAIT_L
#undef PG8_BAR
#undef PG8_SCHED
}
}

#ifndef PG8_SP2
#define PG8_SP2 true
#endif
#ifndef PG8_ALIGN
#define PG8_ALIGN true
#endif
#define LAS __attribute__((address_space(3)))

__device__ __forceinline__ void transpose_item(const float* W, int K, int N, const float* kg, bf16_t* WT, int k0, int n_src0, int p0, LAS float* scr, int lane) {
#pragma unroll 8
    for (int i = 0; i < 32; ++i) { const int kk = 2 * i + (lane >> 5); float w = W[(size_t)(k0 + kk) * N + n_src0 + (lane & 31)]; if (kg) w *= kg[k0 + kk]; scr[kk * 33 + (lane & 31)] = w; }
    asm volatile("s_waitcnt lgkmcnt(0)" ::: "memory");
    const int c = lane & 7;
#pragma unroll
    for (int j = 0; j < 4; ++j) { const int n = (lane >> 3) + 8 * j; const LAS float* s = scr + (8 * c) * 33 + n;
        u32x4 o; o.x = pk2(s[0 * 33], s[1 * 33]); o.y = pk2(s[2 * 33], s[3 * 33]); o.z = pk2(s[4 * 33], s[5 * 33]); o.w = pk2(s[6 * 33], s[7 * 33]);
        *(u32x4*)(WT + (size_t)(p0 + n) * K + k0 + 8 * c) = o; }
    asm volatile("s_waitcnt lgkmcnt(0)" ::: "memory");
}
__device__ __forceinline__ void convert_weights(LAS unsigned char* lds, const float* w_in, const float* w_out, const float* w_ffn_in, const float* norm_ffn, const float* w_down,
                                                bf16_t* WIN, bf16_t* WOUT, bf16_t* WFI, bf16_t* WFD, const float* w_pool, bf16_t* WPT) {
    int tid_ = threadIdx.x; asm volatile("" : "+v"(tid_));
    const int lane = tid_ & 63, wave = tid_ >> 6;
    LAS float* scr = (LAS float*)(lds + wave * 16384);
    const int gw = blockIdx.x * 8 + wave, NGW = gridDim.x * 8;
    constexpr int I_IN = 16 * 40, I_OUT = 16 * 32, I_FI = 16 * 176, I_FD = 44 * 32, I_PL = 32;
    for (int it = gw; it < I_PL + I_IN + I_OUT + I_FI + I_FD; it += NGW) {
        int r = it;
        if (r < I_PL) { const int g = r >> 3, kb = (r >> 2) & 1, grp = r & 3; transpose_item(w_pool + (size_t)g * 16384, 128, 128, nullptr, WPT + (size_t)g * 16384, kb * 64, 32 * grp, 32 * grp, scr, lane); continue; }
        r -= I_PL;
        if (r < I_IN) { const int kb = r / 40, grp = r % 40, pn = grp >> 3, rem = grp & 7, bj = rem >> 2, wc = rem & 3;
            transpose_item(w_in, DM, DIN, nullptr, WIN, kb * 64, 256 * pn + 64 * wc + 32 * bj, 32 * grp, scr, lane); continue; }
        r -= I_IN;
        if (r < I_OUT) { const int kb = r / 32, grp = r % 32; transpose_item(w_out, DM, DM, nullptr, WOUT, kb * 64, 32 * grp, 32 * grp, scr, lane); continue; }
        r -= I_OUT;
        if (r < I_FI) { const int kb = r / 176, grp = r % 176, pn = grp >> 3, rem = grp & 7, bj = rem >> 2, q = rem & 3;
            transpose_item(w_ffn_in, DM, 2 * DFF, norm_ffn, WFI, kb * 64, 128 * pn + 32 * q + bj * DFF, 32 * grp, scr, lane); continue; }
        r -= I_FI;
        { const int kb = r / 32, grp = r % 32; transpose_item(w_down, DFF, DM, nullptr, WFD, kb * 64, 32 * grp, 32 * grp, scr, lane); }
    }
}

struct EpiDownG {
    static constexpr bool PERM = true, AFTER_DRAIN = false;
    float* out; float* ssq;
    __device__ __forceinline__ void operator()(const pg8::f32x4 (&acc)[2][2][4][2], const pg8::Unit& u, int wr, int wc, int fr, int fq) const {
        const int row0 = u.pm * 256 + wr * 64 + fr, col0 = u.pn * 256 + wc * 32 + 8 * fq;
#pragma unroll
        for (int ai = 0; ai < 2; ++ai)
#pragma unroll
            for (int m = 0; m < 4; ++m) {
                const int row = row0 + ai * 128 + m * 16;
                float* rp = out + (size_t)row * DM + col0; float s = 0.f;
#pragma unroll
                for (int bj = 0; bj < 2; ++bj) {
                    f32x4 a = *(const f32x4*)(rp + bj * 128), b = *(const f32x4*)(rp + bj * 128 + 4);
                    a += acc[ai][bj][m][0]; b += acc[ai][bj][m][1];
                    *(f32x4*)(rp + bj * 128) = a; *(f32x4*)(rp + bj * 128 + 4) = b;
                    s += (a.x * a.x + a.y * a.y) + (a.z * a.z + a.w * a.w) + (b.x * b.x + b.y * b.y) + (b.z * b.z + b.w * b.w);
                }
                s += __shfl_xor(s, 16); s += __shfl_xor(s, 32);
                if (fq == 0) ssq[(size_t)row * 16 + u.pn * 4 + wc] = s;
            }
    }
};


typedef unsigned u32x2 __attribute__((ext_vector_type(2)));
struct EpiOutG {
    static constexpr bool PERM = true, AFTER_DRAIN = false;
    const float* x; float* out; bf16_t* A2; float* ssq;
    __device__ __forceinline__ void operator()(const pg8::f32x4 (&acc)[2][2][4][2], const pg8::Unit& u, int wr, int wc, int fr, int fq) const {
        const int row0 = u.pm * 256 + wr * 64 + fr, col0 = u.pn * 256 + wc * 32 + 8 * fq;
#pragma unroll
        for (int ai = 0; ai < 2; ++ai)
#pragma unroll
            for (int m = 0; m < 4; ++m) {
                const int row = row0 + ai * 128 + m * 16;
                const size_t off = (size_t)row * DM + col0; float s = 0.f;
#pragma unroll
                for (int bj = 0; bj < 2; ++bj) {
                    f32x4 a = *(const f32x4*)(x + off + bj * 128), b = *(const f32x4*)(x + off + bj * 128 + 4);
                    a += acc[ai][bj][m][0]; b += acc[ai][bj][m][1];
                    *(f32x4*)(out + off + bj * 128) = a; *(f32x4*)(out + off + bj * 128 + 4) = b;
                    u32x4 w; w.x = pg8::cvt_pk_bf16(a.x, a.y); w.y = pg8::cvt_pk_bf16(a.z, a.w); w.z = pg8::cvt_pk_bf16(b.x, b.y); w.w = pg8::cvt_pk_bf16(b.z, b.w);
                    *(u32x4*)(A2 + off + bj * 128) = w;
                    s += (a.x * a.x + a.y * a.y) + (a.z * a.z + a.w * a.w) + (b.x * b.x + b.y * b.y) + (b.z * b.z + b.w * b.w);
                }
                s += __shfl_xor(s, 16); s += __shfl_xor(s, 32);
                if (fq == 0) ssq[(size_t)row * 16 + u.pn * 4 + wc] = s;
            }
    }
};
__device__ __forceinline__ float silu_mul(float g, float u) { return g * __builtin_amdgcn_rcpf(1.f + __builtin_amdgcn_exp2f(-1.4426950408889634f * g)) * u; }
struct EpiFfnInG {
    static constexpr bool PERM = true, AFTER_DRAIN = false;
    const float* ssq; bf16_t* ACT;
    __device__ __forceinline__ void operator()(const pg8::f32x4 (&acc)[2][2][4][2], const pg8::Unit& u, int wr, int wc, int fr, int fq) const {
        const int row0 = u.pm * 256 + wr * 64 + fr, col0 = u.pn * 128 + wc * 32 + 8 * fq;
#pragma unroll
        for (int ai = 0; ai < 2; ++ai)
#pragma unroll
            for (int m = 0; m < 4; ++m) {
                const int row = row0 + ai * 128 + m * 16;
                const f32x4* sp = (const f32x4*)(ssq + (size_t)row * 16);
                const f32x4 s0 = sp[0], s1 = sp[1], s2 = sp[2], s3 = sp[3];
                const float t = ((s0.x + s0.y) + (s0.z + s0.w)) + ((s1.x + s1.y) + (s1.z + s1.w)) + ((s2.x + s2.y) + (s2.z + s2.w)) + ((s3.x + s3.y) + (s3.z + s3.w));
                const float rs = 1.0f / sqrtf(t * (1.f / DM) + EPS);
                const f32x4 g0 = acc[ai][0][m][0] * rs, g1 = acc[ai][0][m][1] * rs, u0 = acc[ai][1][m][0] * rs, u1 = acc[ai][1][m][1] * rs;
                u32x4 w;
                w.x = pg8::cvt_pk_bf16(silu_mul(g0.x, u0.x), silu_mul(g0.y, u0.y)); w.y = pg8::cvt_pk_bf16(silu_mul(g0.z, u0.z), silu_mul(g0.w, u0.w));
                w.z = pg8::cvt_pk_bf16(silu_mul(g1.x, u1.x), silu_mul(g1.y, u1.y)); w.w = pg8::cvt_pk_bf16(silu_mul(g1.z, u1.z), silu_mul(g1.w, u1.w));
                *(u32x4*)(ACT + (size_t)row * DFF + col0) = w;
            }
    }
};
struct EpiInG {
    static constexpr bool PERM = false, AFTER_DRAIN = false;
    const float* qn; const float* kn; const float* rope; bf16_t* Q; bf16_t* K; bf16_t* V; bf16_t* U;
    __device__ __forceinline__ void operator()(const pg8::f32x4 (&acc)[2][2][4][2], const pg8::Unit& u, int wr, int wc, int fr, int fq) const {
        const int g = 4 * u.pn + wc;
        const int row0 = u.pm * 256 + wr * 64 + fr;
        if (g < 10) {
            const float* gn = g < 8 ? qn : kn;
            f32x4 gv[2][2];
#pragma unroll
            for (int bj = 0; bj < 2; ++bj)
#pragma unroll
                for (int n = 0; n < 2; ++n) gv[bj][n] = *(const f32x4*)(gn + 32 * bj + 16 * n + 4 * fq);
            const float osc = g < 8 ? C2 : 1.f;
            bf16_t* base = g < 8 ? Q + g * 64 : K + (g - 8) * 64; const int pitch = g < 8 ? DATT : DKV;
#pragma unroll
            for (int ai = 0; ai < 2; ++ai)
#pragma unroll
                for (int m = 0; m < 4; ++m) {
                    const int row = row0 + ai * 128 + m * 16;
                    float s = 0.f;
#pragma unroll
                    for (int bj = 0; bj < 2; ++bj)
#pragma unroll
                        for (int n = 0; n < 2; ++n) { const f32x4 v = acc[ai][bj][m][n]; s += (v.x * v.x + v.y * v.y) + (v.z * v.z + v.w * v.w); }
                    s += __shfl_xor(s, 16); s += __shfl_xor(s, 32);
                    const float rn = (1.0f / sqrtf(s * (1.f / 64.f) + EPS));
                    const int sidx = row & (SEQ - 1);
#pragma unroll
                    for (int bj = 0; bj < 2; ++bj) {
                        f32x4 cc = (f32x4){1.f, 1.f, 1.f, 1.f}, ss = (f32x4){0.f, 0.f, 0.f, 0.f};
                        if (row < MR) {
                            const int ci = bj == 0 ? (sidx >> 6) : (sidx & 63);
                            const f32x4* tp = (const f32x4*)(rope + (ci * 16 + 4 * fq) * 2);
                            const f32x4 t0 = tp[0], t1 = tp[1];
                            cc = (f32x4){t0.x, t0.z, t1.x, t1.z}; ss = (f32x4){t0.y, t0.w, t1.y, t1.w};
                        }
                        const f32x4 x0 = acc[ai][bj][m][0] * rn * gv[bj][0], x1 = acc[ai][bj][m][1] * rn * gv[bj][1];
                        const f32x4 o0 = (x0 * cc - x1 * ss) * osc, o1 = (x0 * ss + x1 * cc) * osc;
                        bf16_t* p = base + (size_t)row * pitch + 32 * bj + 4 * fq;
                        u32x2 w0, w1; w0.x = pg8::cvt_pk_bf16(o0.x, o0.y); w0.y = pg8::cvt_pk_bf16(o0.z, o0.w); w1.x = pg8::cvt_pk_bf16(o1.x, o1.y); w1.y = pg8::cvt_pk_bf16(o1.z, o1.w);
                        *(u32x2*)p = w0; *(u32x2*)(p + 16) = w1;
                    }
                }
        } else {
            bf16_t* base = g < 12 ? V + (g - 10) * 64 : U + (g - 12) * 64; const int pitch = g < 12 ? DKV : DPOOL;
#pragma unroll
            for (int ai = 0; ai < 2; ++ai)
#pragma unroll
                for (int m = 0; m < 4; ++m) {
                    const int row = row0 + ai * 128 + m * 16;
#pragma unroll
                    for (int bj = 0; bj < 2; ++bj)
#pragma unroll
                        for (int n = 0; n < 2; ++n) { const f32x4 v = acc[ai][bj][m][n]; u32x2 w; w.x = pg8::cvt_pk_bf16(v.x, v.y); w.y = pg8::cvt_pk_bf16(v.z, v.w);
                            *(u32x2*)(base + (size_t)row * pitch + 32 * bj + 16 * n + 4 * fq) = w; }
                }
        }
    }
};

__device__ __forceinline__ void rope_table(float* tab) {
    for (int idx = blockIdx.x * NTHREADS + threadIdx.x; idx < 64 * 16; idx += gridDim.x * NTHREADS) {
        const int ci = idx >> 4, i = idx & 15;
        const int lo = i & 3, hi = i >> 2;
        double f = lo == 0 ? 1.0 : lo == 1 ? 0.5623413251903491 : lo == 2 ? 0.31622776601683794 : 0.1778279410038923;
        f *= hi == 0 ? 1.0 : hi == 1 ? 0.1 : hi == 2 ? 0.01 : 0.001;
        const float ang_f = (float)(ci - 32) * (float)f;
        double a = (double)ang_f;
        a -= 6.283185307179586 * __builtin_rint(a * 0.15915494309189535);
        const double a2 = a * a;
        double sn = a, cs = 1.0, ts = a, tc = 1.0;
        for (int k = 1; k <= 16; ++k) {
            tc *= -a2 / (double)((2 * k - 1) * (2 * k));
            ts *= -a2 / (double)((2 * k) * (2 * k + 1));
            cs += tc; sn += ts;
        }
        tab[2 * idx] = (float)cs; tab[2 * idx + 1] = (float)sn;
    }
}
__device__ __forceinline__ void rms_rows_p0(const float* x, const float* meta, const float* g, bf16_t* HN) {
    int tid_ = threadIdx.x; asm volatile("" : "+v"(tid_));
    const int lane = tid_ & 63, gw = blockIdx.x * 8 + (tid_ >> 6), NGW = gridDim.x * 8;
    f32x4 gv[4];
#pragma unroll
    for (int j = 0; j < 4; ++j) gv[j] = *((const f32x4*)g + lane + 64 * j);
    for (int m = gw; m < MP; m += NGW) {
        unsigned long long* o8 = (unsigned long long*)(HN + (size_t)m * DM) + lane;
        if (m >= MR + NMETA) {
#pragma unroll
            for (int j = 0; j < 4; ++j) o8[64 * j] = 0ull;
            continue;
        }
        const float* src = m < MR ? x + (size_t)m * DM : meta + (size_t)(m - MR) * DM;
        const f32x4* xr = (const f32x4*)src + lane;
        f32x4 v[4]; float s = 0.f;
#pragma unroll
        for (int j = 0; j < 4; ++j) { v[j] = xr[64 * j]; s += (v[j].x * v[j].x + v[j].y * v[j].y) + (v[j].z * v[j].z + v[j].w * v[j].w); }
        const float rs = 1.0f / sqrtf(wave_sum(s) * (1.f / DM) + EPS);
#pragma unroll
        for (int j = 0; j < 4; ++j) {
            const f32x4 y = v[j] * rs * gv[j];
            o8[64 * j] = (unsigned long long)pk2(y.x, y.y) | ((unsigned long long)pk2(y.z, y.w) << 32);
        }
    }
}

#include <hip/hip_bf16.h>
#include <cmath>
namespace attn_body {
using bf16=__hip_bfloat16;
using bf16x8=__attribute__((ext_vector_type(8)))short;
using s16x4=__attribute__((ext_vector_type(4)))short;
using f32x16=__attribute__((ext_vector_type(16)))float;
using u32x4=__attribute__((ext_vector_type(4)))unsigned;
using f32x4v=__attribute__((ext_vector_type(4)))float;
constexpr int D=64,QP=512,KP=128;
constexpr int NW=8,QBLK=32,KVBLK=64,NT=65,NREAL=64;
__device__ __forceinline__ int crow(int r,int hi){return (r&3)+8*(r>>2)+4*hi;}
#define SBAR() __builtin_amdgcn_sched_barrier(0)
__device__ __forceinline__ void mmask(f32x16&p0,f32x16&p1){
  const float NEG=-INFINITY;
  #pragma unroll
  for(int r=8;r<16;++r)p0[r]=NEG;
  #pragma unroll
  for(int r=0;r<16;++r)p1[r]=NEG;
}

constexpr int NSLOT=3, SLOTB=8192;
constexpr int OB_PITCH=1040;
constexpr int LDS_K=0, LDS_V=NSLOT*SLOTB, LDS_WS=2*NSLOT*SLOTB, LDS_OB=LDS_WS+NW*64*4, LDS_BYTES=LDS_OB+64*OB_PITCH;
constexpr float C2=0.125f*1.4426950408889634f;
__device__ __forceinline__ void glds16(const void*gsrc,unsigned lds_dst){unsigned keep;
  asm volatile("s_mov_b32 %0, m0\n\ts_mov_b32 m0, %2\n\ts_nop 0\n\tglobal_load_lds_dwordx4 %1, off\n\ts_mov_b32 m0, %0":"=&s"(keep):"v"(gsrc),"s"(lds_dst):"memory");}
__device__ __forceinline__ float max3f(float a,float b,float c){float r;asm("v_max3_f32 %0, %1, %2, %3":"=v"(r):"v"(a),"v"(b),"v"(c));return r;}
__device__ __forceinline__ float max2f(float a,float b){float r;asm("v_max_f32_e32 %0, %1, %2":"=v"(r):"v"(a),"v"(b));return r;}
__device__ __forceinline__ float fadd_s(float a,float b){float r;asm("v_add_f32_e32 %0, %1, %2":"=v"(r):"v"(a),"v"(b));return r;}
__device__ __forceinline__ float fsub_s(float a,float b){float r;asm("v_sub_f32_e32 %0, %1, %2":"=v"(r):"v"(a),"v"(b));return r;}
typedef float f32x2_t __attribute__((ext_vector_type(2))); typedef __bf16 bf16x2_t __attribute__((ext_vector_type(2)));
__device__ __forceinline__ unsigned cvtpk_s(float lo,float hi){f32x2_t v={lo,hi};bf16x2_t b=__builtin_convertvector(v,bf16x2_t);return __builtin_bit_cast(unsigned,b);}
#define WAIT_BAR(N) asm volatile("s_waitcnt vmcnt(" #N ") lgkmcnt(0)\n\ts_barrier":::"memory")

__device__ __forceinline__ void qkt(f32x16&p0,f32x16&p1,const char*Kslot,const bf16x8*qr,const f32x16&negm,int r32,int hi){
  const char*kb=Kslot+hi*1024+r32*16;
  #pragma unroll
  for(int d0=0;d0<4;++d0){
    const bf16x8 b0=*reinterpret_cast<const bf16x8*>(kb+d0*2048);
    const bf16x8 b1=*reinterpret_cast<const bf16x8*>(kb+d0*2048+512);
    if(d0==0){p0=__builtin_amdgcn_mfma_f32_32x32x16_bf16(b0,qr[0],negm,0,0,0);p1=__builtin_amdgcn_mfma_f32_32x32x16_bf16(b1,qr[0],negm,0,0,0);}
    else{p0=__builtin_amdgcn_mfma_f32_32x32x16_bf16(b0,qr[d0],p0,0,0,0);p1=__builtin_amdgcn_mfma_f32_32x32x16_bf16(b1,qr[d0],p1,0,0,0);}}
}
typedef __attribute__((address_space(3))) const char* lds_cptr;
typedef short v4i16_t __attribute__((ext_vector_type(4)));
__device__ __forceinline__ void kload8(bf16x8*kf,lds_cptr kp){
  kf[0]=*(const __attribute__((address_space(3))) bf16x8*)(kp);      kf[1]=*(const __attribute__((address_space(3))) bf16x8*)(kp+512);
  kf[2]=*(const __attribute__((address_space(3))) bf16x8*)(kp+2048); kf[3]=*(const __attribute__((address_space(3))) bf16x8*)(kp+2560);
  kf[4]=*(const __attribute__((address_space(3))) bf16x8*)(kp+4096); kf[5]=*(const __attribute__((address_space(3))) bf16x8*)(kp+4608);
  kf[6]=*(const __attribute__((address_space(3))) bf16x8*)(kp+6144); kf[7]=*(const __attribute__((address_space(3))) bf16x8*)(kp+6656);
}
__device__ __forceinline__ void kload2(bf16x8*kf,lds_cptr kp,int j){ kf[2*j]=*(const __attribute__((address_space(3))) bf16x8*)(kp+j*2048); kf[2*j+1]=*(const __attribute__((address_space(3))) bf16x8*)(kp+j*2048+512); }
__device__ __forceinline__ s16x4 vtr(lds_cptr p){ return __builtin_bit_cast(s16x4,__builtin_amdgcn_ds_read_tr16_b64_v4i16((__attribute__((address_space(3))) v4i16_t*)p)); }
__device__ __forceinline__ float rowmax(const f32x16&p0,const f32x16&p1){
  float a=max3f(p0[0],p0[1],p1[0]),b=max3f(p0[2],p0[3],p1[1]);a=max3f(a,p1[2],p1[3]);
  #pragma unroll
  for(int r=4;r<16;r+=4){a=max3f(a,p0[r],p0[r+1]);b=max3f(b,p0[r+2],p0[r+3]);a=max3f(a,p1[r],p1[r+1]);b=max3f(b,p1[r+2],p1[r+3]);}
  const float m=max2f(a,b);
  auto rr=__builtin_amdgcn_permlane32_swap(__float_as_uint(m),__float_as_uint(m),false,false);
  return max2f(__uint_as_float(rr[0]),__uint_as_float(rr[1]));
}
__device__ __forceinline__ void pv(f32x16*o,int vb,bf16x8 pa0,bf16x8 pa1,bf16x8 pa2,bf16x8 pa3){
  #pragma unroll
  for(int d0=0;d0<2;++d0){s16x4 lo[4],hi[4];
    #pragma unroll
    for(int ks=0;ks<4;++ks){
      asm volatile("ds_read_b64_tr_b16 %0,%1 offset:%c2":"=&v"(lo[ks]):"v"(vb),"i"(d0*4096+ks*1024):"memory");
      asm volatile("ds_read_b64_tr_b16 %0,%1 offset:%c2":"=&v"(hi[ks]):"v"(vb),"i"(d0*4096+ks*1024+512):"memory");}
    asm volatile("s_waitcnt lgkmcnt(0)":::"memory");SBAR();
    #define PK(k) (bf16x8){lo[k][0],lo[k][1],lo[k][2],lo[k][3],hi[k][0],hi[k][1],hi[k][2],hi[k][3]}
    o[d0]=__builtin_amdgcn_mfma_f32_32x32x16_bf16(pa0,PK(0),o[d0],0,0,0);
    o[d0]=__builtin_amdgcn_mfma_f32_32x32x16_bf16(pa1,PK(1),o[d0],0,0,0);
    o[d0]=__builtin_amdgcn_mfma_f32_32x32x16_bf16(pa2,PK(2),o[d0],0,0,0);
    o[d0]=__builtin_amdgcn_mfma_f32_32x32x16_bf16(pa3,PK(3),o[d0],0,0,0);
    #undef PK
  }
}

#ifndef ATTN_STORE16
#define ATTN_STORE16(p,v) (*(u32x4*)(p)=(v))
#endif
template<int THRL> __device__ __forceinline__ void attn_unit(int b,int kvh,int rb,const bf16*Q,const bf16*__restrict__ K,const bf16*__restrict__ V,char*shm){
  int tid_=threadIdx.x; asm volatile("":"+v"(tid_));
  const int tid=tid_,lane=tid&63,r32=lane&31,hi=lane>>5; const int wid=__builtin_amdgcn_readfirstlane(tid>>6);
  const long rowbase=(long)b*4096; const int q0=rb*64; const int h=kvh*4+(wid>>1);
  const bf16*Qw=Q+(rowbase+q0+(wid&1)*QBLK)*QP+h*D;
  const bf16*Kh=K+rowbase*KP+kvh*D,*Vh=V+rowbase*KP+kvh*D;
  const long metaoff=((long)32768-rowbase)*KP;
  const unsigned lds0=(unsigned)(uintptr_t)shm;
  float*wsf=(float*)(shm+LDS_WS)+wid*64;
  const bf16*ksrc=Kh+(long)lane*KP+wid*8;
  const bf16*vsrc=Vh+(long)(16*(wid&3)+(lane>>2))*KP+(wid>>2)*32+(lane&3)*8;
  const unsigned kdst=lds0+LDS_K+wid*1024, vdst=lds0+LDS_V+wid*1024;
  #define DMA_K(t,slot) glds16(ksrc+((t)<NREAL?(long)(t)*KVBLK*KP:metaoff),(unsigned)__builtin_amdgcn_readfirstlane(kdst+(slot)))
  #define DMA_V(t,slot) glds16(vsrc+((t)<NREAL?(long)(t)*KVBLK*KP:metaoff),(unsigned)__builtin_amdgcn_readfirstlane(vdst+(slot)))
  const int vb0=(int)(lds0+LDS_V)+((lane>>4)&1)*32+(lane&3)*8+(4*hi+((lane&15)>>2))*64;
  const char*Kbase=shm+LDS_K; bf16x8 kf[8];
  const lds_cptr shm3=(lds_cptr)shm; const lds_cptr kp0=shm3+LDS_K+hi*1024+r32*16; const lds_cptr vp0=shm3+LDS_V+((lane>>4)&1)*32+(lane&3)*8+(4*hi+((lane&15)>>2))*64;
  DMA_K(0,0);DMA_V(0,0);DMA_K(1,SLOTB);
  bf16x8 qr[4];
  #pragma unroll
  for(int d0=0;d0<4;++d0)qr[d0]=*reinterpret_cast<const bf16x8*>(&Qw[(long)r32*QP+d0*16+hi*8]);
  float mhat=0.f,l_reg=0.f;f32x16 o[2];o[0]=f32x16{};o[1]=f32x16{};f32x16 negm=f32x16{};asm volatile("":"+v"(negm));
  #define CMASK(P0,P1,t) do{ if((t)==NT-1)mmask(P0,P1); }while(0)
  bool resc=false;
  #define START(P0,P1) do{ const float rm=rowmax(P0,P1); resc=false; \
    { const float dl=rm; mhat=fadd_s(mhat,dl); \
      _Pragma("unroll") for(int r=0;r<16;++r){P0[r]=fsub_s(P0[r],dl);P1[r]=fsub_s(P1[r],dl);} \
      _Pragma("unroll") for(int r=0;r<16;++r)negm[r]=-mhat; asm volatile("":"+v"(negm)); } \
    _Pragma("unroll") for(int r=0;r<16;++r)P0[r]=__builtin_amdgcn_exp2f(P0[r]); }while(0)
  #define RESC() do{ if(resc){ asm volatile("s_waitcnt lgkmcnt(0)":::"memory"); \
      _Pragma("unroll") for(int d_=0;d_<2;++d_) _Pragma("unroll") for(int r=0;r<16;++r)o[d_][r]*=wsf[crow(r,hi)]; } }while(0)
  f32x16 pA0,pA1,pB0,pB1;
  int sl_prev=0,sl_cur=0,sl_next=SLOTB;
  #define ROT() do{sl_prev=sl_cur;sl_cur=sl_next;sl_next=(sl_next==(NSLOT-1)*SLOTB)?0:sl_next+SLOTB;}while(0)
  DMA_K(2,2*SLOTB);
  WAIT_BAR(3);
  qkt(pA0,pA1,Kbase,qr,negm,r32,hi);asm volatile("s_nop 15\n\ts_nop 7":"+v"(pA0),"+v"(pA1));CMASK(pA0,pA1,0);
  START(pA0,pA1);
  _Pragma("unroll") for(int r=0;r<16;++r)pA1[r]=__builtin_amdgcn_exp2f(pA1[r]);
  WAIT_BAR(0);
  DMA_K(3,0);DMA_V(1,SLOTB);
  ROT();
  kload8(kf,kp0+sl_cur);
  WAIT_BAR(2);
  s16x4 vlo[8],vhi[8]; u32x4 pw0,pw1,pw2,pw3;
  #define PKW(P,B) cvtpk_s(P[B],P[B+1])
  #define PAF(k) __builtin_bit_cast(bf16x8,pw##k)
  #define VFR(i) (bf16x8){vlo[i][0],vlo[i][1],vlo[i][2],vlo[i][3],vhi[i][0],vhi[i][1],vhi[i][2],vhi[i][3]}
  #define PIN(x) asm volatile("":"+v"(x))
  #define MX3(a,b,c) __builtin_fmaxf(__builtin_fmaxf((a),(b)),(c))
  #define GAPA(MF,A0,A1,A2,A3,W0,W1,PW) do{ MF; sacc+=A0; sacc+=A1; sacc+=A2; sacc+=A3; PIN(sacc); W0; W1; PIN(PW); SBAR(); }while(0)
  #define EX(v) __builtin_amdgcn_exp2f(v)
  #define GAPB(MF,X,B) do{ MF; X[B]=EX(X[B]); X[B+1]=EX(X[B+1]); X[B+2]=EX(X[B+2]); X[B+3]=EX(X[B+3]); PIN(X); SBAR(); }while(0)
  #define VRD(i) do{ vlo[i]=vtr(vp_+(((i)>>2)*4096+((i)&3)*1024)); vhi[i]=vtr(vp_+(((i)>>2)*4096+((i)&3)*1024+512)); }while(0)
  #define KRD(G,j) do{ if(G){ kload2(kf,kp0+sl_next,j); SBAR(); } }while(0)
  #define STEP(C0,C1,P0,P1,t,GK,GV,GL) do{ SBAR(); \
    const lds_cptr vp_=vp0+sl_prev; \
    VRD(0); SBAR(); float sacc=(P0[0]+P0[1]); \
    GAPA(C0=__builtin_amdgcn_mfma_f32_32x32x16_bf16(kf[0],qr[0],negm,0,0,0), P0[2],P0[3],P0[4],P0[5],     pw0[0]=PKW(P0,0), pw0[1]=PKW(P0,2), pw0); \
    VRD(4); SBAR(); GAPA(C1=__builtin_amdgcn_mfma_f32_32x32x16_bf16(kf[1],qr[0],negm,0,0,0), P0[6],P0[7],P0[8],P0[9],     pw0[2]=PKW(P0,4), pw0[3]=PKW(P0,6), pw0); \
    VRD(1); SBAR(); GAPA(C0=__builtin_amdgcn_mfma_f32_32x32x16_bf16(kf[2],qr[1],C0,0,0,0),   P0[10],P0[11],P0[12],P0[13], pw1[0]=PKW(P0,8), pw1[1]=PKW(P0,10), pw1); \
    VRD(5); SBAR(); GAPA(C1=__builtin_amdgcn_mfma_f32_32x32x16_bf16(kf[3],qr[1],C1,0,0,0),   P0[14],P0[15],P1[0],P1[1],   pw1[2]=PKW(P0,12),pw1[3]=PKW(P0,14), pw1); \
    VRD(2); SBAR(); GAPA(C0=__builtin_amdgcn_mfma_f32_32x32x16_bf16(kf[4],qr[2],C0,0,0,0),   P1[2],P1[3],P1[4],P1[5],     pw2[0]=PKW(P1,0), pw2[1]=PKW(P1,2), pw2); \
    VRD(6); SBAR(); GAPA(C1=__builtin_amdgcn_mfma_f32_32x32x16_bf16(kf[5],qr[2],C1,0,0,0),   P1[6],P1[7],P1[8],P1[9],     pw2[2]=PKW(P1,4), pw2[3]=PKW(P1,6), pw2); \
    VRD(3); SBAR(); GAPA(C0=__builtin_amdgcn_mfma_f32_32x32x16_bf16(kf[6],qr[3],C0,0,0,0),   P1[10],P1[11],P1[12],P1[13], pw3[0]=PKW(P1,8), pw3[1]=PKW(P1,10), pw3); \
    VRD(7); SBAR(); GAPA(C1=__builtin_amdgcn_mfma_f32_32x32x16_bf16(kf[7],qr[3],C1,0,0,0),   P1[14],P1[15],0.f,0.f,       pw3[2]=PKW(P1,12),pw3[3]=PKW(P1,14), pw3); \
    l_reg+=sacc; \
    if(GK){DMA_K((t)+3,sl_cur);} if(GV){DMA_V((t)+1,sl_next);} \
    CMASK(C0,C1,t); \
    { float a=MX3(C0[0],C0[1],C1[0]),b=MX3(C0[2],C0[3],C1[1]); a=MX3(a,C1[2],C1[3]); \
      _Pragma("unroll") for(int r=4;r<16;r+=4){a=MX3(a,C0[r],C0[r+1]);b=MX3(b,C0[r+2],C0[r+3]);a=MX3(a,C1[r],C1[r+1]);b=MX3(b,C1[r+2],C1[r+3]);} \
      float rm=__builtin_fmaxf(a,b); { auto rr=__builtin_amdgcn_permlane32_swap(__float_as_uint(rm),__float_as_uint(rm),false,false); rm=__builtin_fmaxf(__uint_as_float(rr[0]),__uint_as_float(rr[1])); } \
      resc=false; \
      if(__builtin_expect(__any(rm>(float)THRL),0)){ const float dl=__builtin_fmaxf(rm,0.f); mhat+=dl; \
        _Pragma("unroll") for(int r=0;r<16;++r){C0[r]-=dl;C1[r]-=dl;} \
        _Pragma("unroll") for(int r=0;r<16;++r)negm[r]=-mhat; asm volatile("":"+v"(negm)); \
        const float f=__builtin_amdgcn_exp2f(-dl); l_reg*=f; if(hi==0)wsf[r32]=f; resc=true; } } \
    SBAR(); \
    GAPB(o[0]=__builtin_amdgcn_mfma_f32_32x32x16_bf16(PAF(0),VFR(0),o[0],0,0,0), C0,0); \
    GAPB(o[1]=__builtin_amdgcn_mfma_f32_32x32x16_bf16(PAF(0),VFR(4),o[1],0,0,0), C0,4); \
    KRD(GL,0); GAPB(o[0]=__builtin_amdgcn_mfma_f32_32x32x16_bf16(PAF(1),VFR(1),o[0],0,0,0), C0,8); \
    KRD(GL,1); GAPB(o[1]=__builtin_amdgcn_mfma_f32_32x32x16_bf16(PAF(1),VFR(5),o[1],0,0,0), C0,12); \
    KRD(GL,2); GAPB(o[0]=__builtin_amdgcn_mfma_f32_32x32x16_bf16(PAF(2),VFR(2),o[0],0,0,0), C1,0); \
    KRD(GL,3); GAPB(o[1]=__builtin_amdgcn_mfma_f32_32x32x16_bf16(PAF(2),VFR(6),o[1],0,0,0), C1,4); \
    GAPB(o[0]=__builtin_amdgcn_mfma_f32_32x32x16_bf16(PAF(3),VFR(3),o[0],0,0,0), C1,8); \
    GAPB(o[1]=__builtin_amdgcn_mfma_f32_32x32x16_bf16(PAF(3),VFR(7),o[1],0,0,0), C1,12); \
    }while(0)
  int t=1;
  #undef CMASK
  #define CMASK(P0,P1,t) do{}while(0)
  for(;t+5<NT;t+=2){
    STEP(pB0,pB1,pA0,pA1,t,true,true,true);     WAIT_BAR(2); RESC(); ROT();
    STEP(pA0,pA1,pB0,pB1,t+1,true,true,true);   WAIT_BAR(2); RESC(); ROT();
  }
  #undef CMASK
  #define CMASK(P0,P1,t) do{ if((t)==NT-1)mmask(P0,P1); }while(0)
  #define ENDW(tt) do{ if((tt)+3<NT){WAIT_BAR(2);} else if((tt)+2<NT){WAIT_BAR(1);} else {WAIT_BAR(0);} }while(0)
  for(;t+2<NT;t+=2){
    STEP(pB0,pB1,pA0,pA1,t,(t+3<NT),(t+1<NT),(t+1<NT));       ENDW(t);   RESC(); ROT();
    STEP(pA0,pA1,pB0,pB1,t+1,(t+4<NT),(t+2<NT),(t+2<NT));     ENDW(t+1); RESC(); ROT();
  }
  STEP(pB0,pB1,pA0,pA1,NT-2,false,true,true); WAIT_BAR(0); RESC(); ROT();
  STEP(pA0,pA1,pB0,pB1,NT-1,false,false,false); RESC();
  { float sacc=pA0[0]+pA0[1]; _Pragma("unroll") for(int r=2;r<16;++r)sacc+=pA0[r]; _Pragma("unroll") for(int r=0;r<16;++r)sacc+=pA1[r]; l_reg+=sacc;
    pw0=(u32x4){PKW(pA0,0),PKW(pA0,2),PKW(pA0,4),PKW(pA0,6)};pw1=(u32x4){PKW(pA0,8),PKW(pA0,10),PKW(pA0,12),PKW(pA0,14)};pw2=(u32x4){PKW(pA1,0),PKW(pA1,2),PKW(pA1,4),PKW(pA1,6)};pw3=(u32x4){PKW(pA1,8),PKW(pA1,10),PKW(pA1,12),PKW(pA1,14)};
    SBAR(); pv(o,vb0+sl_cur,PAF(0),PAF(1),PAF(2),PAF(3)); }
  #undef PKW
  #undef PAF
  #undef VFR
  #undef PIN
  #undef MX3
  #undef GAPA
  #undef GAPB
  #undef EX
  #undef VRD
  #undef KRD
  #undef STEP
  #undef ENDW
  {auto rr=__builtin_amdgcn_permlane32_swap(__float_as_uint(l_reg),__float_as_uint(l_reg),false,false);l_reg=__uint_as_float(rr[0])+__uint_as_float(rr[1]);}
  if(hi==0)wsf[32+r32]=l_reg;asm volatile("s_waitcnt lgkmcnt(0)":::"memory");
  float rli[16];
  #pragma unroll
  for(int r=0;r<16;++r)rli[r]=__builtin_amdgcn_rcpf(wsf[32+crow(r,hi)]);
  { char*ob=shm+LDS_OB+((wid&1)*QBLK)*OB_PITCH+h*128;
    #pragma unroll
    for(int r=0;r<16;++r){const int orow=crow(r,hi);
      #pragma unroll
      for(int d0=0;d0<2;++d0)*(bf16*)(ob+orow*OB_PITCH+(d0*32+r32)*2)=__float2bfloat16(o[d0][r]*rli[r]);} }
  asm volatile("s_waitcnt lgkmcnt(0)\n\ts_barrier":::"memory");
  #undef DMA_K
  #undef DMA_V
  #undef CMASK
  #undef START
  #undef RESC
  #undef ROT
}
constexpr int ATTN_LDS_BYTES=LDS_BYTES;
__device__ __forceinline__ void attn_rows_out(long m0,const float*gain,unsigned short*MIX,char*shm){
  int tid_=threadIdx.x; asm volatile("":"+v"(tid_));
  const int tid=tid_,lane=tid&63; const int wid=__builtin_amdgcn_readfirstlane(tid>>6);
  const f32x4v g0=*(const f32x4v*)(gain+lane*8),g1=*(const f32x4v*)(gain+lane*8+4);
  #pragma unroll
  for(int i=0;i<8;++i){ const int row=wid*8+i;
    const u32x4 v=*(const u32x4*)(shm+LDS_OB+row*OB_PITCH+lane*16);
    float f[8]; f[0]=__uint_as_float(v[0]<<16);f[1]=__uint_as_float(v[0]&0xffff0000u);f[2]=__uint_as_float(v[1]<<16);f[3]=__uint_as_float(v[1]&0xffff0000u);
    f[4]=__uint_as_float(v[2]<<16);f[5]=__uint_as_float(v[2]&0xffff0000u);f[6]=__uint_as_float(v[3]<<16);f[7]=__uint_as_float(v[3]&0xffff0000u);
    float ss=0.f;
    #pragma unroll
    for(int j=0;j<8;++j)ss+=f[j]*f[j];
    #pragma unroll
    for(int o_=1;o_<64;o_<<=1)ss+=__shfl_xor(ss,o_);
    const float rs=1.0f/sqrtf(ss*(1.f/512.f)+1e-6f);
    u32x4 w; w[0]=cvtpk_s(f[0]*rs*g0[0],f[1]*rs*g0[1]); w[1]=cvtpk_s(f[2]*rs*g0[2],f[3]*rs*g0[3]); w[2]=cvtpk_s(f[4]*rs*g1[0],f[5]*rs*g1[1]); w[3]=cvtpk_s(f[6]*rs*g1[2],f[7]*rs*g1[3]);
    *(u32x4*)(MIX+(m0+row)*1024+lane*8)=w; }
  asm volatile("s_waitcnt lgkmcnt(0)\n\ts_barrier":::"memory");
}
template<int THRL=8> __device__ __forceinline__ void attn_phase(char*lds,const bf16*Q,const bf16*K,const bf16*V,const float*gain,unsigned short*MIX,int vcu,int ncu){
  for(int blk=vcu;blk<512;blk+=ncu){ const int b=blk>>6, rb=blk&63;
    attn_unit<THRL>(b,0,rb,Q,K,V,lds); attn_unit<THRL>(b,1,rb,Q,K,V,lds);
    attn_rows_out((long)b*4096+rb*64,gain,MIX,lds); }
}
#undef SBAR
#undef WAIT_BAR
}

__device__ __forceinline__ void pool_phase(LAS unsigned char* lds, const bf16_t* U, const bf16_t* WPT, const float* pscale, bf16_t* MIX) {
    int tid_ = threadIdx.x; asm volatile("" : "+v"(tid_));
    const int tid = tid_, lane = tid & 63, wid = __builtin_amdgcn_readfirstlane(tid >> 6);
    const int fr = lane & 15, fq = lane >> 4;
    constexpr int PITCH = 1040;
    LAS float* red = (LAS float*)(lds + 80 * PITCH);
    const int mt = wid & 3, gsel = wid >> 2;
    for (int blk = blockIdx.x; blk < MR / 64; blk += gridDim.x) {
        const int m0 = blk * 64, b = m0 >> 12, s0 = m0 & (SEQ - 1);
#pragma unroll
        for (int i = 0; i < 10; ++i) {
            const int idx = i * 512 + tid, row = idx >> 6, c = idx & 63, p = s0 - 8 + row;
            u32x4 v = (u32x4){0u, 0u, 0u, 0u};
            if (p < SEQ) { const int grow = p >= 0 ? b * SEQ + p : MR + NMETA + p; v = *(const u32x4*)(U + (size_t)grow * DPOOL + c * 8); }
            *(LAS u32x4*)(lds + row * PITCH + c * 16) = v;
        }
        __syncthreads();
        f32x4 acc[2][8];
#pragma unroll
        for (int gi = 0; gi < 2; ++gi)
#pragma unroll
            for (int nt = 0; nt < 8; ++nt) acc[gi][nt] = (f32x4){0.f, 0.f, 0.f, 0.f};
        const int tl = mt * 16 + fr;
#pragma unroll
        for (int gi = 0; gi < 2; ++gi) {
            const int g = gi == 0 ? gsel : 3 - gsel, w2 = 1 << g;
            int cnt = SEQ - (s0 + tl) + w2; cnt = cnt < 2 * w2 ? cnt : 2 * w2;
            const float inv = 1.0f / (float)cnt;
            for (int ks = 0; ks < 4; ++ks) {
                pg8::bf16x8 bfr[8];
#pragma unroll
                for (int nt = 0; nt < 8; ++nt) bfr[nt] = *(const pg8::bf16x8*)(WPT + ((size_t)(g * 128 + nt * 16 + fr) * 128 + ks * 32 + 8 * fq));
                const int chb = g * 128 + ks * 32 + 8 * fq;
                float sum[8];
#pragma unroll
                for (int j = 0; j < 8; ++j) sum[j] = 0.f;
                LAS const unsigned char* base = lds + (tl + 8 - w2) * PITCH + chb * 2;
#pragma unroll 2
                for (int r = 0; r < 2 * w2; ++r) {
                    const u32x4 v = *(LAS const u32x4*)(base + r * PITCH);
                    sum[0] += __uint_as_float(v.x << 16); sum[1] += __uint_as_float(v.x & 0xffff0000u); sum[2] += __uint_as_float(v.y << 16); sum[3] += __uint_as_float(v.y & 0xffff0000u);
                    sum[4] += __uint_as_float(v.z << 16); sum[5] += __uint_as_float(v.z & 0xffff0000u); sum[6] += __uint_as_float(v.w << 16); sum[7] += __uint_as_float(v.w & 0xffff0000u);
                }
                const u32x4 sv = *(LAS const u32x4*)(lds + (tl + 8) * PITCH + chb * 2);
                u32x4 aw;
                aw.x = pg8::cvt_pk_bf16(sum[0] * inv - __uint_as_float(sv.x << 16), sum[1] * inv - __uint_as_float(sv.x & 0xffff0000u));
                aw.y = pg8::cvt_pk_bf16(sum[2] * inv - __uint_as_float(sv.y << 16), sum[3] * inv - __uint_as_float(sv.y & 0xffff0000u));
                aw.z = pg8::cvt_pk_bf16(sum[4] * inv - __uint_as_float(sv.z << 16), sum[5] * inv - __uint_as_float(sv.z & 0xffff0000u));
                aw.w = pg8::cvt_pk_bf16(sum[6] * inv - __uint_as_float(sv.w << 16), sum[7] * inv - __uint_as_float(sv.w & 0xffff0000u));
                const pg8::bf16x8 a = __builtin_bit_cast(pg8::bf16x8, aw);
#pragma unroll
                for (int nt = 0; nt < 8; ++nt) acc[gi][nt] = __builtin_amdgcn_mfma_f32_16x16x32_bf16(a, bfr[nt], acc[gi][nt], 0, 0, 0);
            }
        }
        float ps[4];
#pragma unroll
        for (int reg = 0; reg < 4; ++reg) { float s = 0.f;
#pragma unroll
            for (int gi = 0; gi < 2; ++gi)
#pragma unroll
                for (int nt = 0; nt < 8; ++nt) s += acc[gi][nt][reg] * acc[gi][nt][reg];
            s += __shfl_xor(s, 1); s += __shfl_xor(s, 2); s += __shfl_xor(s, 4); s += __shfl_xor(s, 8);
            ps[reg] = s; }
        if (fr == 0) {
#pragma unroll
            for (int reg = 0; reg < 4; ++reg) red[(mt * 16 + fq * 4 + reg) * 2 + gsel] = ps[reg];
        }
        __syncthreads();
        float rs[4];
#pragma unroll
        for (int reg = 0; reg < 4; ++reg) { const int row = mt * 16 + fq * 4 + reg; rs[reg] = 1.0f / sqrtf((red[row * 2] + red[row * 2 + 1]) * (1.f / DPOOL) + EPS); }
#pragma unroll
        for (int gi = 0; gi < 2; ++gi) {
            const int g = gi == 0 ? gsel : 3 - gsel;
#pragma unroll
            for (int nt = 0; nt < 8; ++nt) {
                const int ch = g * 128 + nt * 16 + fr; const float sc = pscale[ch];
#pragma unroll
                for (int reg = 0; reg < 4; ++reg) *(LAS bf16_t*)(lds + (mt * 16 + fq * 4 + reg) * PITCH + ch * 2) = (bf16_t)f2bf(acc[gi][nt][reg] * rs[reg] * sc);
            }
        }
        __syncthreads();
#pragma unroll
        for (int i = 0; i < 8; ++i) {
            const int idx = i * 512 + tid, row = idx >> 6, c = idx & 63;
            const u32x4 v = *(LAS const u32x4*)(lds + row * PITCH + c * 16);
            *(u32x4*)(MIX + (size_t)(m0 + row) * DM + DATT + c * 8) = v;
        }
        __syncthreads();
    }
}

__device__ __forceinline__ void final_norm(float* out, const float* ssq, const float* g) {
    int tid_ = threadIdx.x; asm volatile("" : "+v"(tid_));
    const int lane = tid_ & 63, gw = blockIdx.x * 8 + (tid_ >> 6), NGW = gridDim.x * 8;
    f32x4 gv[4];
#pragma unroll
    for (int j = 0; j < 4; ++j) gv[j] = *((const f32x4*)g + lane + 64 * j);
    for (int m = gw; m < MR; m += NGW) {
        float t = 0.f;
#pragma unroll
        for (int i = 0; i < 16; ++i) t += ssq[(size_t)m * 16 + i];
        const float rs = 1.0f / sqrtf(t * (1.f / DM) + EPS);
        f32x4* xr = (f32x4*)(out + (size_t)m * DM) + lane;
#pragma unroll
        for (int j = 0; j < 4; ++j) xr[64 * j] = xr[64 * j] * rs * gv[j];
    }
}

#define XB_TMO      128
#define XB_XCNT(j)  (256  + 64 * (j))
#define XB_XSUB(j)  (1280 + 64 * (j))
#define XB_XGEN(j)  (2304 + 64 * (j))
#define XB_TOP      3328
#define XB_TOPGEN   3392
#define XCD_BAR_WORDS 3456
#define XB_SPIN_CAP (1u << 18)

__device__ __forceinline__ unsigned xb_ld(unsigned* p)              { return __hip_atomic_load(p, __ATOMIC_RELAXED, __HIP_MEMORY_SCOPE_AGENT); }
__device__ __forceinline__ unsigned xb_add(unsigned* p, unsigned v) { return __hip_atomic_fetch_add(p, v, __ATOMIC_RELAXED, __HIP_MEMORY_SCOPE_AGENT); }
__device__ __forceinline__ unsigned xb_xcc_id() { return (unsigned)__builtin_amdgcn_s_getreg((3 << 11) | 20) & 0xFu; }
#define XB_SPIN(cond, bar) do { unsigned _sp = 0; while (cond) { __builtin_amdgcn_s_sleep(1); \
    if ((++_sp & 255u) == 0u) { if (xb_ld(&(bar)[XB_TMO])) break; if (_sp > XB_SPIN_CAP) { atomicAdd(&(bar)[XB_TMO], 1u); break; } } } } while (0)

struct XcdBarrier {
    unsigned* bar; unsigned x;
    volatile LAS unsigned* st;
};

__device__ __forceinline__ XcdBarrier xcd_barrier_post(unsigned* bar, volatile LAS unsigned* st) {
    XcdBarrier b; b.bar = bar; b.x = xb_xcc_id(); b.st = st;
    if (threadIdx.x == 0) (void)xb_add(&bar[XB_XCNT(b.x)], 1u);
    return b;
}
__device__ __forceinline__ void xcd_barrier_complete(unsigned* bar, unsigned x, unsigned& nloc, unsigned& nx) {
    const unsigned G = gridDim.x * gridDim.y * gridDim.z;
    unsigned sum, cnt, mine, sp = 0u;
    for (;;) {
        sum = 0u; cnt = 0u; mine = 0u;
#pragma unroll
        for (unsigned j = 0; j < 16; ++j) { const unsigned c = xb_ld(&bar[XB_XCNT(j)]); sum += c; cnt += (c > 0u) ? 1u : 0u; mine = (j == x) ? c : mine; }
        if (sum == G) break;
        __builtin_amdgcn_s_sleep(1);
        if ((++sp & 255u) == 0u) { if (xb_ld(&bar[XB_TMO])) break; if (sp > XB_SPIN_CAP) { atomicAdd(&bar[XB_TMO], 1u); break; } }
    }
    nloc = mine > 0u ? mine : 1u; nx = cnt > 0u ? cnt : 1u;
}

__device__ __forceinline__ void xcd_barrier(const XcdBarrier& b) {
    asm volatile("s_waitcnt vmcnt(0)" ::: "memory");
    __syncthreads();
    if (threadIdx.x == 0) {
        unsigned* bar = b.bar;
        __builtin_amdgcn_s_waitcnt(0);
        unsigned nloc = b.st[0], nx = b.st[1];
        if (nloc == 0u) { xcd_barrier_complete(bar, b.x, nloc, nx); b.st[0] = nloc; b.st[1] = nx; }
        const unsigned old = xb_add(&bar[XB_XSUB(b.x)], 1u);
        const unsigned gen = old / nloc;
        if (old + 1u == (gen + 1u) * nloc) {
            __builtin_amdgcn_fence(__ATOMIC_RELEASE, "agent");
            asm volatile("s_waitcnt vmcnt(0)" ::: "memory");
            const unsigned og = xb_add(&bar[XB_TOP], 1u);
            const unsigned tg = og / nx;
            if (og + 1u == (tg + 1u) * nx) xb_add(&bar[XB_TOPGEN], 1u);
            else XB_SPIN(xb_ld(&bar[XB_TOPGEN]) == tg, bar);
            __builtin_amdgcn_fence(__ATOMIC_ACQUIRE, "agent");
            xb_add(&bar[XB_XGEN(b.x)], 1u);
            asm volatile("s_waitcnt vmcnt(0)" ::: "memory");
        } else {
            XB_SPIN(xb_ld(&bar[XB_XGEN(b.x)]) == gen, bar);
            __builtin_amdgcn_fence(__ATOMIC_ACQUIRE, "agent");
            asm volatile("s_waitcnt vmcnt(0)" ::: "memory");
        }
    }
    __syncthreads();
}

__global__ void __launch_bounds__(NTHREADS, 2) fwd_kernel(Args args) {
    extern __shared__ __attribute__((aligned(16))) unsigned char lds_raw[];
    float* lds = (float*)lds_raw;
    cg::grid_group grid = cg::this_grid();
    volatile LAS unsigned* MISC = (volatile LAS unsigned*)((LAS unsigned char*)lds_raw + 131072 + 320);
    if (threadIdx.x < 32) MISC[threadIdx.x] = 0u;
    __syncthreads();
    XcdBarrier xbar = xcd_barrier_post((unsigned*)args.ws, MISC + 8);
    unsigned char* ws = args.ws;
    const float* x = args.in[0]; const float* meta = args.in[1]; const float* norm_mix = args.in[2]; const float* w_in = args.in[3];
    const float* q_norm = args.in[4]; const float* k_norm = args.in[5]; const float* attn_out_norm = args.in[6]; const float* w_pool = args.in[7];
    const float* pool_scale = args.in[8]; const float* w_out = args.in[9]; const float* norm_ffn = args.in[10]; const float* w_ffn_in = args.in[11];
    const float* w_ffn_down = args.in[12]; const float* norm_final = args.in[13];
    float* rope = (float*)(ws + WS_ROPE);
    bf16_t* HN = (bf16_t*)(ws + WS_HN); bf16_t* Q = (bf16_t*)(ws + WS_Q); bf16_t* K = (bf16_t*)(ws + WS_K); bf16_t* V = (bf16_t*)(ws + WS_V);
    bf16_t* U = (bf16_t*)(ws + WS_U); bf16_t* MIX = (bf16_t*)(ws + WS_MIX); bf16_t* A2 = (bf16_t*)(ws + WS_A2); bf16_t* ACT = (bf16_t*)(ws + WS_ACT);
    float* SSQ2 = (float*)(ws + WS_SSQ2); float* SSQ3 = (float*)(ws + WS_SSQ3);

    bf16_t* WIN = (bf16_t*)(ws + WS_WIN); bf16_t* WOUT = (bf16_t*)(ws + WS_WOUT); bf16_t* WFI = (bf16_t*)(ws + WS_WFI); bf16_t* WFD = (bf16_t*)(ws + WS_WFD);
    LAS unsigned char* ldsl = (LAS unsigned char*)lds_raw;
    rope_table(rope);
    bf16_t* WPT = (bf16_t*)(ws + WS_WPOOL);
    convert_weights(ldsl, w_in, w_out, w_ffn_in, norm_ffn, w_ffn_down, WIN, WOUT, WFI, WFD, w_pool, WPT);
    rms_rows_p0(x, meta, norm_mix, HN);
    grid.sync();
    { pg8::Gemm g{HN, WIN, MP, DIN, DM}; pg8::StaticOrder S; S.init(MP, DIN, (int)gridDim.x, (int)blockIdx.x); EpiInG e{q_norm, k_norm, rope, Q, K, V, U};
      pg8::gemm_phase<EpiInG, pg8::StaticOrder, PG8_ALIGN, PG8_SP2>(ldsl, g, S, e); }
    xcd_barrier(xbar);
    { const int G = (int)gridDim.x, bx = (int)blockIdx.x; const int vcu = (G % 8 == 0) ? (bx % 8) * (G / 8) + bx / 8 : bx;
      attn_body::attn_phase<8>((char*)lds_raw, (const attn_body::bf16*)Q, (const attn_body::bf16*)K, (const attn_body::bf16*)V, attn_out_norm, MIX, vcu, G); }
    pool_phase(ldsl, U, WPT, pool_scale, MIX);
    xcd_barrier(xbar);
    { pg8::Gemm g{MIX, WOUT, MR, DM, DM}; pg8::StaticOrder S; S.init(MR, DM, (int)gridDim.x, (int)blockIdx.x); EpiOutG e{x, args.out, A2, SSQ2};
      pg8::gemm_phase<EpiOutG, pg8::StaticOrder, PG8_ALIGN, PG8_SP2>(ldsl, g, S, e); }
    xcd_barrier(xbar);
    { pg8::Gemm g{A2, WFI, MR, 2 * DFF, DM}; pg8::StaticOrder S; S.init(MR, 2 * DFF, (int)gridDim.x, (int)blockIdx.x); EpiFfnInG e{SSQ2, ACT};
      pg8::gemm_phase<EpiFfnInG, pg8::StaticOrder, PG8_ALIGN, PG8_SP2>(ldsl, g, S, e); }
    xcd_barrier(xbar);
    { pg8::Gemm g{ACT, WFD, MR, DM, DFF}; pg8::StaticOrder S; S.init(MR, DM, (int)gridDim.x, (int)blockIdx.x); EpiDownG e{args.out, SSQ3};
      pg8::gemm_phase<EpiDownG, pg8::StaticOrder, PG8_ALIGN, PG8_SP2>(ldsl, g, S, e); }
    xcd_barrier(xbar);
    final_norm(args.out, SSQ3, norm_final);
}

extern "C" void kernel_launch(void* const* d_in, const int* in_sizes, int n_in, void* d_out, int out_size, void* d_ws, size_t ws_size, hipStream_t stream) {
    static int grid = 0;
    if (grid == 0) {
        int dev = 0, cus = 0, per_cu = 0;
        hipGetDevice(&dev);
        hipDeviceGetAttribute(&cus, hipDeviceAttributeMultiprocessorCount, dev);
        hipFuncSetAttribute((const void*)fwd_kernel, hipFuncAttributeMaxDynamicSharedMemorySize, LDS_BYTES);
        hipOccupancyMaxActiveBlocksPerMultiprocessor(&per_cu, (const void*)fwd_kernel, NTHREADS, LDS_BYTES);
        if (per_cu < 1) { fprintf(stderr, "kernel_launch: occupancy query says %d blocks per CU\n", per_cu); per_cu = 1; }
        (void)hipGetLastError();
        grid = cus;
    }
    if (hipMemsetAsync(d_ws, 0, 16384, stream) != hipSuccess) { fprintf(stderr, "kernel_launch: hipMemsetAsync failed\n"); return; }
    Args a{};
    for (int i = 0; i < 14; ++i) a.in[i] = (const float*)d_in[i];
    a.out = (float*)d_out; a.ws = (unsigned char*)d_ws;
    void* params[] = {&a};
    hipError_t e = hipLaunchCooperativeKernel((const void*)fwd_kernel, dim3(grid), dim3(NTHREADS), params, LDS_BYTES, stream);
    if (e != hipSuccess) fprintf(stderr, "cooperative launch failed: %s (grid %d)\n", hipGetErrorString(e), grid);
}
```
